# Optimizing an MI355X kernel written in HIP

```python
import jax
import jax.numpy as jnp
from jax import lax
import numpy as np

D_MODEL = 2048
BATCH = 1
SEQ = 8192
DEPTH = 2

MEM_LEN = 256
EPS = 1e-6
NEG_INF = -1e30

N_BRANCH = 3
BRANCH_WIDTH = D_MODEL // 2

MOBA_HEADS = 8
MOBA_HEAD_DIM = 128
MOBA_WIDTH = MOBA_HEADS * MOBA_HEAD_DIM
MOBA_BLOCK = 256
MOBA_TOPK = 3
MOBA_Q_CHUNK = 64
ROPE_THETA = 10000.0

GLA_HEADS = 4
GLA_DK = 128
GLA_DV = 256
GLA_K_WIDTH = GLA_HEADS * GLA_DK
GLA_V_WIDTH = GLA_HEADS * GLA_DV
GLA_RANK = 16
GLA_TAU = 16.0
GLA_CHUNK = 64

POOL_WINDOWS = (2, 4, 8, 16)
POOL_GROUPS = 4
POOL_GROUP_DIM = 256
POOL_WIDTH = POOL_GROUPS * POOL_GROUP_DIM

IN_SPLITS = (MOBA_WIDTH, MOBA_WIDTH, MOBA_WIDTH, GLA_K_WIDTH, GLA_K_WIDTH, GLA_V_WIDTH, GLA_V_WIDTH, GLA_RANK, POOL_WIDTH)
IN_WIDTH = 3 * MOBA_WIDTH + 2 * GLA_K_WIDTH + 2 * GLA_V_WIDTH + GLA_RANK + POOL_WIDTH

XATTN_HEADS = 4
XATTN_HEAD_DIM = 128
XATTN_WIDTH = XATTN_HEADS * XATTN_HEAD_DIM

MOE_GROUPS = 8
MOE_EXPERTS_PER_GROUP = 8
MOE_EXPERTS = MOE_GROUPS * MOE_EXPERTS_PER_GROUP
MOE_TOPK = 2
MOE_D_FF = 512
MOE_ROW_BLOCK = 128

kernel_name = "hybrid_moba_gla_pool_hmoe"


def rms_norm(x, g):
    xf = x.astype(jnp.float32)
    y = xf * lax.rsqrt(jnp.mean(xf * xf, axis=-1, keepdims=True) + EPS)
    return (y * g.astype(jnp.float32)).astype(x.dtype)


def rope_tables(positions):
    inv = 1.0 / (ROPE_THETA ** (jnp.arange(0, MOBA_HEAD_DIM, 2, dtype=jnp.float32) / MOBA_HEAD_DIM))
    ang = positions.astype(jnp.float32)[:, None, :, None] * inv
    return jnp.cos(ang), jnp.sin(ang)


def apply_rope(x, cos, sin):
    x1, x2 = jnp.split(x.astype(jnp.float32), 2, axis=-1)
    return jnp.concatenate([x1 * cos - x2 * sin, x2 * cos + x1 * sin], axis=-1).astype(x.dtype)


def moba_attention(q, k, v):
    B, H, S, hd = q.shape
    BLK, QC = MOBA_BLOCK, MOBA_Q_CHUNK
    nb = -(-S // BLK)
    s_pad = nb * BLK
    pad = ((0, 0), (0, 0), (0, s_pad - S), (0, 0))
    q, k, v = jnp.pad(q, pad), jnp.pad(k, pad), jnp.pad(v, pad)
    kb = k.reshape(B, H, nb, BLK, hd)
    vb = v.reshape(B, H, nb, BLK, hd)
    k_mean = jnp.mean(kb.astype(jnp.float32), axis=3)
    topk = min(MOBA_TOPK, nb)
    n_chunks = s_pad // QC
    q_chunks = jnp.moveaxis(q.reshape(B, H, n_chunks, QC, hd), 2, 0)
    scale = hd ** -0.5
    bi = jnp.arange(B)[:, None, None, None]
    hi = jnp.arange(H)[None, :, None, None]

    def one_chunk(args):
        q_c, c = args
        q_pos = c * QC + jnp.arange(QC)
        own = (c * QC) // BLK
        gate = jnp.einsum('bhqd,bhnd->bhqn', q_c.astype(jnp.float32), k_mean)
        gate = jnp.where(jnp.arange(nb) < own, gate, NEG_INF)
        _, idx = lax.top_k(gate, topk)
        k_sel = kb[bi, hi, idx]
        v_sel = vb[bi, hi, idx]
        s_sel = jnp.einsum('bhqd,bhqnkd->bhqnk', q_c, k_sel, preferred_element_type=jnp.float32) * scale
        s_sel = jnp.where((jnp.arange(topk) < own)[:, None], s_sel, NEG_INF)
        k_own = lax.dynamic_index_in_dim(kb, own, axis=2, keepdims=False)
        v_own = lax.dynamic_index_in_dim(vb, own, axis=2, keepdims=False)
        s_own = jnp.einsum('bhqd,bhkd->bhqk', q_c, k_own, preferred_element_type=jnp.float32) * scale
        s_own = jnp.where(own * BLK + jnp.arange(BLK)[None, :] <= q_pos[:, None], s_own, NEG_INF)
        scores = jnp.concatenate([s_sel.reshape(B, H, QC, topk * BLK), s_own], axis=-1)
        p = jax.nn.softmax(scores, axis=-1).astype(v.dtype)
        p_sel = p[..., :topk * BLK].reshape(B, H, QC, topk, BLK)
        p_own = p[..., topk * BLK:]
        out = (jnp.einsum('bhqnk,bhqnkd->bhqd', p_sel, v_sel, preferred_element_type=jnp.float32)
               + jnp.einsum('bhqk,bhkd->bhqd', p_own, v_own, preferred_element_type=jnp.float32))
        return out.astype(q.dtype)

    out = lax.map(one_chunk, (q_chunks, jnp.arange(n_chunks)))
    out = jnp.moveaxis(out, 0, 2).reshape(B, H, s_pad, hd)
    return out[:, :, :S]


def gla_attention(q, k, v, log_a):
    B, H, S, dk = q.shape
    dv = v.shape[-1]
    C = GLA_CHUNK
    nc = S // C

    def chunked(t):
        return t.astype(jnp.float32).reshape(B, H, nc, C, t.shape[-1])

    q = chunked(q) * (dk ** -0.5)
    k = chunked(k)
    v = chunked(v)
    b = jnp.cumsum(chunked(log_a), axis=3)
    b_last = b[:, :, :, -1:, :]
    q_dec = q * jnp.exp(b)
    k_inv = k * jnp.exp(-b)
    k_end = k * jnp.exp(b_last - b)
    causal = jnp.tril(jnp.ones((C, C), dtype=bool))
    attn = jnp.where(causal, jnp.einsum('bhncd,bhnjd->bhncj', q_dec, k_inv), 0.0)
    o_intra = jnp.einsum('bhncj,bhnje->bhnce', attn, v)

    def step(state, inp):
        q_c, k_c, v_c, decay_c = inp
        o_c = jnp.einsum('bhcd,bhde->bhce', q_c, state)
        state = decay_c[..., None] * state + jnp.einsum('bhcd,bhce->bhde', k_c, v_c)
        return state, o_c

    xs = (jnp.moveaxis(q_dec, 2, 0), jnp.moveaxis(k_end, 2, 0), jnp.moveaxis(v, 2, 0),
          jnp.moveaxis(jnp.exp(b_last[:, :, :, 0, :]), 2, 0))
    _, o_inter = lax.scan(step, jnp.zeros((B, H, dk, dv), jnp.float32), xs)
    o = o_intra + jnp.moveaxis(o_inter, 0, 2)
    return o.reshape(B, H, S, dv)


def pool_mixer(u, w_pool, pool_scale):
    B, S, _ = u.shape
    uf = u.astype(jnp.float32).reshape(B, S, POOL_GROUPS, POOL_GROUP_DIM)
    cs = jnp.concatenate([jnp.zeros_like(uf[:, :1]), jnp.cumsum(uf, axis=1)], axis=1)
    t = jnp.arange(S)[:, None]
    win = jnp.array(POOL_WINDOWS, dtype=jnp.int32)[None, :]
    start = jnp.maximum(t + 1 - win, 0)
    count = (t + 1 - start).astype(jnp.float32)
    window_sum = cs[:, 1:] - cs[:, start, jnp.arange(POOL_GROUPS)[None, :]]
    mixed = window_sum / count[None, :, :, None] - uf
    y = jnp.einsum('bsgc,gce->bsge', mixed, w_pool.astype(jnp.float32)).reshape(B, S, POOL_WIDTH)
    return (y * pool_scale.astype(jnp.float32)).astype(u.dtype)


def token_mixing(h, cos, sin, w_in, w_gla_decay, b_gla_decay, gla_norm, w_pool, pool_scale,
                 w_branch, w_gate, b_gate, w_mix_out):
    B, S, D = h.shape
    proj = h @ w_in
    pieces = []
    start = 0
    for width in IN_SPLITS:
        pieces.append(proj[..., start:start + width])
        start += width
    mq, mk, mv, gq, gk, gv, gr, g_low, pu = pieces

    def heads(t, n):
        return t.reshape(B, S, n, -1).transpose(0, 2, 1, 3)

    mq = apply_rope(heads(mq, MOBA_HEADS), cos, sin)
    mk = apply_rope(heads(mk, MOBA_HEADS), cos, sin)
    o_moba = moba_attention(mq, mk, heads(mv, MOBA_HEADS))
    o_moba = o_moba.transpose(0, 2, 1, 3).reshape(B, S, MOBA_WIDTH).astype(h.dtype)
    log_a = jax.nn.log_sigmoid((g_low @ w_gla_decay + b_gla_decay).astype(jnp.float32)) / GLA_TAU
    o_gla = gla_attention(heads(gq, GLA_HEADS), heads(gk, GLA_HEADS), heads(gv, GLA_HEADS), heads(log_a, GLA_HEADS))
    o_gla = rms_norm(o_gla.transpose(0, 2, 1, 3), gla_norm).reshape(B, S, GLA_V_WIDTH)
    o_gla = (o_gla * jax.nn.silu(gr.astype(jnp.float32))).astype(h.dtype)
    o_pool = pool_mixer(pu, w_pool, pool_scale)
    branches = jnp.stack([o_moba, o_gla, o_pool], axis=2)
    y = jnp.einsum('bsnc,ncd->bsnd', branches, w_branch)
    gates = jax.nn.sigmoid(h @ w_gate + b_gate).reshape(B, S, N_BRANCH, D)
    merged = jnp.sum(gates * y, axis=2)
    return merged @ w_mix_out


def cross_attention(h, mem_n, w_q, w_kv, w_o):
    B, S, _ = h.shape
    M = mem_n.shape[1]
    q = (h @ w_q).reshape(B, S, XATTN_HEADS, XATTN_HEAD_DIM)
    kv = (mem_n @ w_kv).reshape(B, M, 2, XATTN_HEADS, XATTN_HEAD_DIM)
    k, v = kv[:, :, 0], kv[:, :, 1]
    s = jnp.einsum('bshd,bmhd->bhsm', q, k, preferred_element_type=jnp.float32) * (XATTN_HEAD_DIM ** -0.5)
    p = jax.nn.softmax(s, axis=-1).astype(v.dtype)
    o = jnp.einsum('bhsm,bmhd->bshd', p, v)
    return o.reshape(B, S, XATTN_WIDTH) @ w_o


def hier_moe(h, w_route_group, b_route_group, w_route_expert, b_route_expert, w1, w3, w2):
    B, S, D = h.shape
    N = B * S
    E, RB = MOE_EXPERTS, MOE_ROW_BLOCK
    t = h.reshape(N, D)
    g_prob = jax.nn.softmax((t @ w_route_group).astype(jnp.float32) + b_route_group, axis=-1)
    g_w, g_idx = lax.top_k(g_prob, 1)
    e_logits = ((t @ w_route_expert).astype(jnp.float32) + b_route_expert).reshape(N, MOE_GROUPS, MOE_EXPERTS_PER_GROUP)
    e_logits = jnp.take_along_axis(e_logits, g_idx[:, :, None], axis=1)[:, 0]
    e_w, e_local = lax.top_k(jax.nn.softmax(e_logits, axis=-1), MOE_TOPK)
    weights = g_w * e_w / jnp.sum(e_w, axis=-1, keepdims=True)
    expert = g_idx * MOE_EXPERTS_PER_GROUP + e_local
    A = N * MOE_TOPK
    e_flat = expert.reshape(A)
    tok_flat = jnp.repeat(jnp.arange(N, dtype=jnp.int32), MOE_TOPK)
    w_flat = weights.reshape(A)
    order = jnp.argsort(e_flat)
    e_sorted = e_flat[order]
    counts = jnp.zeros((E,), jnp.int32).at[e_flat].add(1)
    starts = jnp.cumsum(counts) - counts
    padded = (counts + RB - 1) // RB * RB
    pad_ends = jnp.cumsum(padded)
    pad_starts = pad_ends - padded
    dest = pad_starts[e_sorted] + (jnp.arange(A) - starts[e_sorted])
    n_blocks = (A + E * (RB - 1) + RB - 1) // RB
    P = n_blocks * RB
    row_tok = jnp.zeros((P,), jnp.int32).at[dest].set(tok_flat[order])
    row_w = jnp.zeros((P,), jnp.float32).at[dest].set(w_flat[order])
    block_expert = jnp.minimum(jnp.searchsorted(pad_ends, jnp.arange(n_blocks) * RB, side='right'), E - 1)
    x_rows = t[row_tok].reshape(n_blocks, RB, D)

    def expert_block(args):
        xb, e = args
        return (jax.nn.silu(xb @ w1[e]) * (xb @ w3[e])) @ w2[e]

    y_rows = lax.map(expert_block, (x_rows, block_expert)).reshape(P, D)
    y = jnp.zeros((N, D), jnp.float32).at[row_tok].add(y_rows.astype(jnp.float32) * row_w[:, None])
    return y.astype(h.dtype).reshape(B, S, D)


def setup_inputs(seed: int = 0) -> dict:
    key = jax.random.key(seed)
    ks = iter(jax.random.split(key, 32))
    f32 = jnp.float32
    L, D = DEPTH, D_MODEL

    def w(shape, fan_in):
        return jax.random.normal(next(ks), shape, f32) * (fan_in ** -0.5)

    def gain(shape):
        return 1.0 + 0.05 * jax.random.normal(next(ks), shape, f32)

    def bias(shape, s=0.02):
        return s * jax.random.normal(next(ks), shape, f32)

    return {
        "x": jax.random.normal(next(ks), (BATCH, SEQ, D), f32),
        "mem": jax.random.normal(next(ks), (BATCH, MEM_LEN, D), f32),
        "positions": jnp.broadcast_to(jnp.arange(SEQ, dtype=jnp.int32)[None, :], (BATCH, SEQ)),
        "norm_mix": gain((L, D)),
        "w_in": w((L, D, IN_WIDTH), D),
        "w_gla_decay": w((L, GLA_RANK, GLA_K_WIDTH), GLA_RANK),
        "b_gla_decay": bias((L, GLA_K_WIDTH), 0.5),
        "gla_norm": gain((L, GLA_DV)),
        "w_pool": w((L, POOL_GROUPS, POOL_GROUP_DIM, POOL_GROUP_DIM), POOL_GROUP_DIM),
        "pool_scale": gain((L, POOL_WIDTH)),
        "w_branch": w((L, N_BRANCH, BRANCH_WIDTH, D), BRANCH_WIDTH),
        "w_gate": w((L, D, N_BRANCH * D), D),
        "b_gate": bias((L, N_BRANCH * D)),
        "w_mix_out": w((L, D, D), D),
        "norm_xattn": gain((L, D)),
        "norm_mem": gain((L, D)),
        "w_xq": w((L, D, XATTN_WIDTH), D),
        "w_xkv": w((L, D, 2 * XATTN_WIDTH), D),
        "w_xo": w((L, XATTN_WIDTH, D), XATTN_WIDTH),
        "norm_moe": gain((L, D)),
        "w_route_group": w((L, D, MOE_GROUPS), D),
        "b_route_group": bias((L, MOE_GROUPS), 0.01),
        "w_route_expert": w((L, D, MOE_EXPERTS), D),
        "b_route_expert": bias((L, MOE_EXPERTS), 0.01),
        "w_exp_gate": w((L, MOE_EXPERTS, D, MOE_D_FF), D),
        "w_exp_up": w((L, MOE_EXPERTS, D, MOE_D_FF), D),
        "w_exp_down": w((L, MOE_EXPERTS, MOE_D_FF, D), MOE_D_FF),
        "norm_final": gain((D,)),
    }


def reference(x, mem, positions, norm_mix, w_in, w_gla_decay, b_gla_decay, gla_norm, w_pool, pool_scale,
              w_branch, w_gate, b_gate, w_mix_out, norm_xattn, norm_mem, w_xq, w_xkv, w_xo, norm_moe,
              w_route_group, b_route_group, w_route_expert, b_route_expert, w_exp_gate, w_exp_up, w_exp_down,
              norm_final):
    cos, sin = rope_tables(positions)
    for l in range(DEPTH):
        h = rms_norm(x, norm_mix[l])
        x = x + token_mixing(h, cos, sin, w_in[l], w_gla_decay[l], b_gla_decay[l], gla_norm[l], w_pool[l],
                             pool_scale[l], w_branch[l], w_gate[l], b_gate[l], w_mix_out[l])
        x = x + cross_attention(rms_norm(x, norm_xattn[l]), rms_norm(mem, norm_mem[l]), w_xq[l], w_xkv[l], w_xo[l])
        x = x + hier_moe(rms_norm(x, norm_moe[l]), w_route_group[l], b_route_group[l], w_route_expert[l],
                         b_route_expert[l], w_exp_gate[l], w_exp_up[l], w_exp_down[l])
    return rms_norm(x, norm_final)
```

```cpp
#include <hip/hip_runtime.h>
#include <cstdio>
#include <cstdint>

#ifndef DBG_STOP
#define DBG_STOP -1
#endif
#ifndef MK_ONE_LAUNCH
#define MK_ONE_LAUNCH 0
#endif

namespace {
#define LAS __attribute__((address_space(3)))
typedef unsigned short bf16;
typedef short bf16x8 __attribute__((ext_vector_type(8)));
typedef float f32x4 __attribute__((ext_vector_type(4)));
typedef unsigned u32x4 __attribute__((ext_vector_type(4)));
typedef unsigned u32x2 __attribute__((ext_vector_type(2)));

constexpr int NT = 8192, DM = 2048, NLAYER = 2, MEMLEN = 256;
constexpr int INW = 7184, GATEW = 6144;
constexpr int C_MQ = 0, C_MK = 1024, C_MV = 2048, C_GQ = 3072, C_GK = 3584, C_GV = 4096, C_GR = 5120, C_PU = 6144, C_GLOW = 7168, C_GATE = 7424;
constexpr int LD1 = C_GATE + GATEW;
constexpr int NEXP = 64, DFF = 512, TMOE = 128, PMAX = 16384 + NEXP * TMOE;
constexpr float EPS = 1e-6f;

constexpr size_t MiB = 1u << 20;
constexpr size_t WS_CTL = 0, CTL_BYTES = 1 * MiB;
constexpr size_t WS_ROPE = 2 * MiB;
constexpr size_t WS_RSTD = 6 * MiB;
constexpr size_t WS_RSTDM = WS_RSTD + 64 * 1024;
constexpr size_t WS_KMEAN = 7 * MiB;
constexpr size_t WS_KVM = 8 * MiB;
constexpr size_t WS_MB = 9 * MiB;
constexpr size_t WS_ROUTE = 10 * MiB;
constexpr size_t WS_GDEC = 11 * MiB;
constexpr size_t WS_LOGITS = 12 * MiB;
constexpr size_t WS_TOKOF = 16 * MiB;
constexpr size_t WS_WL = 32 * MiB;
constexpr size_t WL_W1T = 0;
constexpr size_t WL_WBRT = 56 * MiB;
constexpr size_t WL_WPOOLT = 68 * MiB;
constexpr size_t WL_WMIXT = 69 * MiB;
constexpr size_t WL_WXQT = 77 * MiB;
constexpr size_t WL_WXKVT = 79 * MiB;
constexpr size_t WL_WXOT = 83 * MiB;
constexpr size_t WL_WRT = 85 * MiB;
constexpr size_t WL_W13T = 86 * MiB;
constexpr size_t WL_W2T = 342 * MiB;
constexpr size_t WL_SIZE = 470 * MiB;
constexpr size_t WS_ACTS = WS_WL + 2 * WL_SIZE;
constexpr size_t WS_XF = WS_ACTS;
constexpr size_t WS_XB = WS_XF + 64 * MiB;
constexpr size_t WS_P1 = WS_XB + 32 * MiB;
constexpr size_t WS_OMOBA = WS_P1 + 216 * MiB;
constexpr size_t WS_OGLA = WS_OMOBA + 16 * MiB;
constexpr size_t WS_MIXED = WS_OGLA + 16 * MiB;
constexpr size_t WS_OPOOL = WS_MIXED + 16 * MiB;
constexpr size_t WS_QDEC = WS_OPOOL + 16 * MiB;
constexpr size_t WS_OINTRA = WS_QDEC + 8 * MiB;
constexpr size_t WS_GKV = WS_OINTRA + 32 * MiB;
constexpr size_t WS_MERGED = WS_GKV + 64 * MiB;
constexpr size_t WS_XQ = WS_MERGED + 32 * MiB;
constexpr size_t WS_XO = WS_XQ + 8 * MiB;
constexpr size_t WS_XS = WS_XO + 8 * MiB;
constexpr size_t WS_ACT = WS_XS + 96 * MiB;
constexpr size_t WS_Y = WS_ACT + 24 * MiB;
constexpr size_t WS_END = WS_Y + 96 * MiB;
static_assert((size_t)PMAX * 2048 * 2 <= 96 * MiB && (size_t)LD1 * 2048 * 2 <= 56 * MiB && (size_t)NT * LD1 * 2 <= 216 * MiB, "map");
constexpr int CW_BAR = 4096;
constexpr int CW_CNT = 16384;
constexpr int RT_EXP = 0, RT_RANK = 2 * NT, RT_DEST = 4 * NT, RT_WGT = 6 * NT, RT_CNT = 8 * NT;

constexpr int LDS_BYTES = 147456;
constexpr int MISC_OFF = 147456 - 256;

__device__ __forceinline__ float bflo(unsigned w) { return __uint_as_float(w << 16); }
__device__ __forceinline__ float bfhi(unsigned w) { return __uint_as_float(w & 0xffff0000u); }
__device__ __forceinline__ float bf2f(bf16 b) { return __uint_as_float((unsigned)b << 16); }
__device__ __forceinline__ unsigned pk2(float lo, float hi) { unsigned r; asm("v_cvt_pk_bf16_f32 %0, %1, %2" : "=v"(r) : "v"(lo), "v"(hi)); return r; }
__device__ __forceinline__ float wave_sum(float v) {
#pragma unroll
    for (int o = 1; o < 64; o <<= 1) v += __shfl_xor(v, o);
    return v;
}
__device__ __forceinline__ float wave_max(float v) {
#pragma unroll
    for (int o = 1; o < 64; o <<= 1) v = fmaxf(v, __shfl_xor(v, o));
    return v;
}
__device__ __forceinline__ float sigmoidf_(float x) { return 1.0f / (1.0f + __expf(-x)); }

#define XB_TMO      128
#define XB_XCNT(j)  (256  + 64 * (j))
#define XB_XSUB(j)  (1280 + 64 * (j))
#define XB_XGEN(j)  (2304 + 64 * (j))
#define XB_TOP      3328
#define XB_TOPGEN   3392
#define XCD_BAR_WORDS 3456
#define XB_SPIN_CAP (1u << 18)

__device__ __forceinline__ unsigned xb_ld(unsigned* p)              { return __hip_atomic_load(p, __ATOMIC_RELAXED, __HIP_MEMORY_SCOPE_AGENT); }
__device__ __forceinline__ unsigned xb_add(unsigned* p, unsigned v) { return __hip_atomic_fetch_add(p, v, __ATOMIC_RELAXED, __HIP_MEMORY_SCOPE_AGENT); }
__device__ __forceinline__ unsigned xb_xcc_id() { return (unsigned)__builtin_amdgcn_s_getreg((3 << 11) | 20) & 0xFu; }
#define XB_SPIN(cond, bar) do { unsigned _sp = 0; while (cond) { __builtin_amdgcn_s_sleep(1); \
    if ((++_sp & 255u) == 0u) { if (xb_ld(&(bar)[XB_TMO])) break; if (_sp > XB_SPIN_CAP) { atomicAdd(&(bar)[XB_TMO], 1u); break; } } } } while (0)

struct XcdBarrier { unsigned* bar; unsigned x; volatile LAS unsigned* st; };

__device__ __forceinline__ XcdBarrier xcd_barrier_post(unsigned* bar, volatile LAS unsigned* st) {
    XcdBarrier b; b.bar = bar; b.x = xb_xcc_id(); b.st = st;
    if (threadIdx.x == 0) (void)xb_add(&bar[XB_XCNT(b.x)], 1u);
    return b;
}
__device__ __forceinline__ void xcd_barrier_complete(unsigned* bar, unsigned x, unsigned& nloc, unsigned& nx) {
    const unsigned G = gridDim.x * gridDim.y * gridDim.z;
    unsigned sum, cnt, mine, sp = 0u;
    for (;;) {
        sum = 0u; cnt = 0u; mine = 0u;
#pragma unroll
        for (unsigned j = 0; j < 16; ++j) { const unsigned c = xb_ld(&bar[XB_XCNT(j)]); sum += c; cnt += (c > 0u) ? 1u : 0u; mine = (j == x) ? c : mine; }
        if (sum == G) break;
        __builtin_amdgcn_s_sleep(1);
        if ((++sp & 255u) == 0u) { if (xb_ld(&bar[XB_TMO])) break; if (sp > XB_SPIN_CAP) { atomicAdd(&bar[XB_TMO], 1u); break; } }
    }
    nloc = mine > 0u ? mine : 1u; nx = cnt > 0u ? cnt : 1u;
}
__device__ __forceinline__ void xcd_barrier(const XcdBarrier& b) {
    asm volatile("s_waitcnt vmcnt(0)" ::: "memory");
    __syncthreads();
    if (threadIdx.x == 0) {
        unsigned* bar = b.bar;
        __builtin_amdgcn_s_waitcnt(0);
        unsigned nloc = b.st[0], nx = b.st[1];
        if (nloc == 0u) { xcd_barrier_complete(bar, b.x, nloc, nx); b.st[0] = nloc; b.st[1] = nx; }
        const unsigned old = xb_add(&bar[XB_XSUB(b.x)], 1u);
        const unsigned gen = old / nloc;
        if (old + 1u == (gen + 1u) * nloc) {
            __builtin_amdgcn_fence(__ATOMIC_RELEASE, "agent");
            asm volatile("s_waitcnt vmcnt(0)" ::: "memory");
            const unsigned og = xb_add(&bar[XB_TOP], 1u);
            const unsigned tg = og / nx;
            if (og + 1u == (tg + 1u) * nx) xb_add(&bar[XB_TOPGEN], 1u);
            else XB_SPIN(xb_ld(&bar[XB_TOPGEN]) == tg, bar);
            __builtin_amdgcn_fence(__ATOMIC_ACQUIRE, "agent");
            xb_add(&bar[XB_XGEN(b.x)], 1u);
            asm volatile("s_waitcnt vmcnt(0)" ::: "memory");
        } else {
            XB_SPIN(xb_ld(&bar[XB_XGEN(b.x)]) == gen, bar);
            __builtin_amdgcn_fence(__ATOMIC_ACQUIRE, "agent");
            asm volatile("s_waitcnt vmcnt(0)" ::: "memory");
        }
    }
    __syncthreads();
}

constexpr int SG_LDS = 2 * 128 * 80;
__device__ __forceinline__ void sg_tile_rows(LAS unsigned char* lds, const bf16* __restrict__ arow, const bf16* __restrict__ brow, int K, f32x4 (&acc)[2][4], const int tid) {
    const int lane = tid & 63, wid = tid >> 6, wm = wid >> 1, wn = wid & 1;
    const int lr = tid >> 2, lc = tid & 3, fr = lane & 15, fq = lane >> 4;
    const u32x4* ga = (const u32x4*)arow + lc;
    const u32x4* gb = (const u32x4*)brow + lc;
    u32x4 ra = ga[0], rb = gb[0];
#pragma unroll 1
    for (int k0 = 0; k0 < K; k0 += 32) {
        __syncthreads();
        *(LAS u32x4*)(lds + lr * 80 + lc * 16) = ra;
        *(LAS u32x4*)(lds + 10240 + lr * 80 + lc * 16) = rb;
        __syncthreads();
        if (k0 + 32 < K) { ra = ga[(k0 + 32) >> 3]; rb = gb[(k0 + 32) >> 3]; }
        bf16x8 af[2], bfr[4];
#pragma unroll
        for (int mt = 0; mt < 2; ++mt) af[mt] = *(const LAS bf16x8*)(lds + (wm * 32 + mt * 16 + fr) * 80 + fq * 16);
#pragma unroll
        for (int nt = 0; nt < 4; ++nt) bfr[nt] = *(const LAS bf16x8*)(lds + 10240 + (wn * 64 + nt * 16 + fr) * 80 + fq * 16);
#pragma unroll
        for (int mt = 0; mt < 2; ++mt)
#pragma unroll
            for (int nt = 0; nt < 4; ++nt) acc[mt][nt] = __builtin_amdgcn_mfma_f32_16x16x32_bf16(bfr[nt], af[mt], acc[mt][nt], 0, 0, 0);
    }
}
__device__ __forceinline__ void sg_tile(LAS unsigned char* lds, const bf16* __restrict__ A, int lda, const bf16* __restrict__ Bt, int ldb, int K, f32x4 (&acc)[2][4], const int tid) {
    sg_tile_rows(lds, A + (size_t)(tid >> 2) * lda, Bt + (size_t)(tid >> 2) * ldb, K, acc, tid);
}
__device__ __forceinline__ void sg_zero(f32x4 (&acc)[2][4]) {
#pragma unroll
    for (int mt = 0; mt < 2; ++mt)
#pragma unroll
        for (int nt = 0; nt < 4; ++nt) acc[mt][nt] = (f32x4){0.f, 0.f, 0.f, 0.f};
}
#define SG_FOREACH(acc, ROW, COL, V, ...) do { const int _l = tid & 63, _w = tid >> 6; \
    _Pragma("unroll") for (int _mt = 0; _mt < 2; ++_mt) _Pragma("unroll") for (int _nt = 0; _nt < 4; ++_nt) { \
        const int ROW = (_w >> 1) * 32 + _mt * 16 + (_l & 15), COL = (_w & 1) * 64 + _nt * 16 + (_l >> 4) * 4; const f32x4 V = acc[_mt][_nt]; __VA_ARGS__ } } while (0)

struct MapOff { int off; __device__ __forceinline__ int operator()(int c) const { return off + c; } };
struct MapRope { __device__ __forceinline__ int operator()(int c) const { if (c >= 2048) return c; const int d = c & 127; const int j = (d < 64) ? 2 * d : 2 * (d - 64) + 1; return (c & ~127) + j; } };
struct MapIl { int par; __device__ __forceinline__ int operator()(int c) const { return 2 * c + par; } };
template <class Map>
__device__ __forceinline__ void transpose_mat(const float* __restrict__ W, int ldw, int K, int ncols, bf16* WT, int ldt, const float* __restrict__ kscale, Map map, LAS float* scr, int gw, int ngw, int lane) {
    const int nblk = ncols / 32, items = (K / 64) * nblk;
    for (int it = gw; it < items; it += ngw) {
        const int kb = it / nblk, nb = it % nblk, k0 = 64 * kb, n0 = 32 * nb;
#pragma unroll 8
        for (int i = 0; i < 32; ++i) { const int kk = 2 * i + (lane >> 5); float v = W[(size_t)(k0 + kk) * ldw + n0 + (lane & 31)]; if (kscale) v *= kscale[k0 + kk]; scr[kk * 33 + (lane & 31)] = v; }
        asm volatile("s_waitcnt lgkmcnt(0)" ::: "memory");
        const int c = lane & 7;
#pragma unroll
        for (int j = 0; j < 4; ++j) { const int n = (lane >> 3) + 8 * j; const LAS float* s = scr + (8 * c) * 33 + n;
            u32x4 o; o.x = pk2(s[0 * 33], s[1 * 33]); o.y = pk2(s[2 * 33], s[3 * 33]); o.z = pk2(s[4 * 33], s[5 * 33]); o.w = pk2(s[6 * 33], s[7 * 33]);
            *(u32x4*)(WT + (size_t)map(n0 + n) * ldt + k0 + 8 * c) = o; }
        asm volatile("s_waitcnt lgkmcnt(0)" ::: "memory");
    }
}
__device__ __forceinline__ void transpose_small(const float* __restrict__ W, int ldw, int K, int ncols, bf16* WT, int ldt, int row_off, const float* __restrict__ kscale, int gt, int ngt) {
    for (int i = gt; i < K * ncols; i += ngt) { const int n = i / K, k = i % K; float v = W[(size_t)k * ldw + n]; if (kscale) v *= kscale[k]; WT[(size_t)(row_off + n) * ldt + k] = (bf16)(pk2(v, 0.f) & 0xffffu); }
}

__device__ __forceinline__ float rbias(const float* brg, const float* bre, int col) { return col < 8 ? brg[col] : (col < 72 ? bre[col - 8] : 0.f); }
struct Args { const void* in[28]; float* out; unsigned char* ws; int ph_lo, ph_hi; };
enum { I_X = 0, I_MEM, I_POS, I_NORM_MIX, I_W_IN, I_W_GLA_DECAY, I_B_GLA_DECAY, I_GLA_NORM, I_W_POOL, I_POOL_SCALE, I_W_BRANCH, I_W_GATE, I_B_GATE, I_W_MIX_OUT,
       I_NORM_XATTN, I_NORM_MEM, I_W_XQ, I_W_XKV, I_W_XO, I_NORM_MOE, I_W_RG, I_B_RG, I_W_RE, I_B_RE, I_W_EG, I_W_EU, I_W_ED, I_NORM_FINAL };

static_assert(sizeof(Args) == 248 && __builtin_offsetof(Args, out) == 224 && __builtin_offsetof(Args, ws) == 232, "kernarg layout");
constexpr int NPH_PRE = 2, NPH_LAYER = 17, NPH = NPH_PRE + NLAYER * NPH_LAYER;

__device__ __forceinline__ void row_prep(const float* xr, bf16* xb, float* rstd_out, int lane) {
    float ss = 0.f; f32x4 v[8];
#pragma unroll
    for (int j = 0; j < 8; ++j) { v[j] = ((const f32x4*)xr)[lane + 64 * j]; ss += (v[j].x * v[j].x + v[j].y * v[j].y) + (v[j].z * v[j].z + v[j].w * v[j].w); }
    ss = wave_sum(ss);
#pragma unroll
    for (int j = 0; j < 8; ++j) { u32x2 o; o.x = pk2(v[j].x, v[j].y); o.y = pk2(v[j].z, v[j].w); ((u32x2*)xb)[lane + 64 * j] = o; }
    if (lane == 0) *rstd_out = 1.0f / sqrtf(ss * (1.0f / DM) + EPS);
}

#define PTRS() unsigned char* wsl = ws; asm volatile("" : "+s"(wsl)); \
    const void* const* kin = (const void* const*)__builtin_amdgcn_kernarg_segment_ptr(); asm volatile("" : "+s"(kin)); \
    int tid = tid0; asm volatile("" : "+v"(tid)); int bid = bid0; asm volatile("" : "+s"(bid)); \
    const int lane = tid & 63, wave = __builtin_amdgcn_readfirstlane(tid >> 6), G = gridDim.x; \
    const int gw = bid * 8 + wave, ngw = G * 8, gt = bid * 512 + tid, ngt = G * 512; (void)gw; (void)ngw; (void)gt; (void)ngt; (void)lane; (void)kin; \
    float* ROPE = (float*)(wsl + WS_ROPE); \
    float* RSTD = (float*)(wsl + WS_RSTD); \
    float* RSTDM = (float*)(wsl + WS_RSTDM); \
    float* KMEAN = (float*)(wsl + WS_KMEAN); \
    bf16* MB = (bf16*)(wsl + WS_MB); \
    int* ROUTE = (int*)(wsl + WS_ROUTE); \
    float* GDEC = (float*)(wsl + WS_GDEC); \
    float* LOGITS = (float*)(wsl + WS_LOGITS); \
    int* TOKOF = (int*)(wsl + WS_TOKOF); \
    float* XF = (float*)(wsl + WS_XF); \
    bf16* XB = (bf16*)(wsl + WS_XB); \
    bf16* P1 = (bf16*)(wsl + WS_P1); \
    bf16* OMOBA = (bf16*)(wsl + WS_OMOBA); \
    bf16* OGLA = (bf16*)(wsl + WS_OGLA); \
    bf16* MIXED = (bf16*)(wsl + WS_MIXED); \
    bf16* OPOOL = (bf16*)(wsl + WS_OPOOL); \
    bf16* QDEC = (bf16*)(wsl + WS_QDEC); \
    float* OINTRA = (float*)(wsl + WS_OINTRA); \
    float* GKV = (float*)(wsl + WS_GKV); \
    bf16* MERGED = (bf16*)(wsl + WS_MERGED); \
    bf16* XQ = (bf16*)(wsl + WS_XQ); \
    bf16* XO = (bf16*)(wsl + WS_XO); \
    bf16* XS = (bf16*)(wsl + WS_XS); \
    bf16* ACT = (bf16*)(wsl + WS_ACT); \
    bf16* YB = (bf16*)(wsl + WS_Y);
__global__ void __launch_bounds__(512, 2) mk_fwd(Args a) {
    extern __shared__ __attribute__((aligned(16))) unsigned char lds_raw[];
    LAS unsigned char* lds = (LAS unsigned char*)lds_raw;
    const int tid0 = threadIdx.x, bid0 = blockIdx.x;
    unsigned char* ws = a.ws;
    unsigned* ctl = (unsigned*)(ws + WS_CTL);
    volatile LAS unsigned* MISC = (volatile LAS unsigned*)(lds + MISC_OFF);
    if (tid0 < 64) MISC[tid0] = 0u;
    __syncthreads();
    XcdBarrier bar; bar.bar = ctl + CW_BAR; bar.x = 0; bar.st = nullptr;
#if MK_ONE_LAUNCH
    bar = xcd_barrier_post(ctl + CW_BAR, MISC + 8);
#endif
    const int lo = a.ph_lo, hi = a.ph_hi;
#ifndef PH_MASK
#define PH_MASK 0x7ffffu
#endif
#define PHON(j) (((PH_MASK) >> (j)) & 1u)
#define IN(k) (lo <= (k) && (k) < hi)
#define SEAM(k) do { if (IN(k) && IN((k) + 1)) xcd_barrier(bar); } while (0)

    if (PHON(17) && IN(0)) { PTRS();
        LAS float* scr = (LAS float*)(lds + wave * 8448);
        for (int l = 0; l < NLAYER; ++l) {
            unsigned char* wl = ws + WS_WL + (size_t)l * WL_SIZE;
            bf16* W1T = (bf16*)(wl + WL_W1T);
            const float* nmix = (const float*)kin[I_NORM_MIX] + l * DM;
            const float* w_in = (const float*)kin[I_W_IN] + (size_t)l * DM * INW;
            transpose_mat(w_in, INW, DM, 6144, W1T, DM, nmix, MapRope{}, scr, gw, ngw, lane);
            transpose_mat(w_in + 6160, INW, DM, 1024, W1T, DM, nmix, MapOff{C_PU}, scr, gw, ngw, lane);
            transpose_small(w_in + 6144, INW, DM, 16, W1T, DM, C_GLOW, nmix, gt, ngt);
            for (int i = gt; i < (C_GATE - C_GLOW - 16) * DM / 8; i += ngt) ((u32x4*)(W1T + (size_t)(C_GLOW + 16) * DM))[i] = (u32x4){0u, 0u, 0u, 0u};
            transpose_mat((const float*)kin[I_W_GATE] + (size_t)l * DM * GATEW, GATEW, DM, GATEW, W1T, DM, nmix, MapOff{C_GATE}, scr, gw, ngw, lane);
            for (int n = 0; n < 3; ++n)
                transpose_mat((const float*)kin[I_W_BRANCH] + ((size_t)l * 3 + n) * 1024 * DM, DM, 1024, DM, (bf16*)(wl + WL_WBRT) + (size_t)n * DM * 1024, 1024, nullptr, MapOff{0}, scr, gw, ngw, lane);
            for (int g = 0; g < 4; ++g)
                transpose_mat((const float*)kin[I_W_POOL] + ((size_t)l * 4 + g) * 256 * 256, 256, 256, 256, (bf16*)(wl + WL_WPOOLT) + (size_t)g * 256 * 256, 256, nullptr, MapOff{0}, scr, gw, ngw, lane);
            transpose_mat((const float*)kin[I_W_MIX_OUT] + (size_t)l * DM * DM, DM, DM, DM, (bf16*)(wl + WL_WMIXT), DM, nullptr, MapOff{0}, scr, gw, ngw, lane);
            transpose_mat((const float*)kin[I_W_XQ] + (size_t)l * DM * 512, 512, DM, 512, (bf16*)(wl + WL_WXQT), DM, (const float*)kin[I_NORM_XATTN] + l * DM, MapOff{0}, scr, gw, ngw, lane);
            transpose_mat((const float*)kin[I_W_XKV] + (size_t)l * DM * 1024, 1024, DM, 1024, (bf16*)(wl + WL_WXKVT), DM, (const float*)kin[I_NORM_MEM] + l * DM, MapOff{0}, scr, gw, ngw, lane);
            transpose_mat((const float*)kin[I_W_XO] + (size_t)l * 512 * DM, DM, 512, DM, (bf16*)(wl + WL_WXOT), 512, nullptr, MapOff{0}, scr, gw, ngw, lane);
            const float* nmoe = (const float*)kin[I_NORM_MOE] + l * DM;
            bf16* WRT = (bf16*)(wl + WL_WRT);
            transpose_small((const float*)kin[I_W_RG] + (size_t)l * DM * 8, 8, DM, 8, WRT, DM, 0, nmoe, gt, ngt);
            transpose_small((const float*)kin[I_W_RE] + (size_t)l * DM * 64, 64, DM, 64, WRT, DM, 8, nmoe, gt, ngt);
            for (int i = gt; i < (128 - 72) * DM / 8; i += ngt) ((u32x4*)(WRT + (size_t)72 * DM))[i] = (u32x4){0u, 0u, 0u, 0u};
            for (int e = 0; e < NEXP; ++e) {
                bf16* W13 = (bf16*)(wl + WL_W13T) + (size_t)e * 1024 * DM;
                transpose_mat((const float*)kin[I_W_EG] + ((size_t)l * NEXP + e) * DM * DFF, DFF, DM, DFF, W13, DM, nmoe, MapIl{0}, scr, gw, ngw, lane);
                transpose_mat((const float*)kin[I_W_EU] + ((size_t)l * NEXP + e) * DM * DFF, DFF, DM, DFF, W13, DM, nmoe, MapIl{1}, scr, gw, ngw, lane);
                transpose_mat((const float*)kin[I_W_ED] + ((size_t)l * NEXP + e) * DFF * DM, DM, DFF, DM, (bf16*)(wl + WL_W2T) + (size_t)e * DM * DFF, DFF, nullptr, MapOff{0}, scr, gw, ngw, lane);
            }
        }
        for (int i = gt; i < NT * 64; i += ngt) {
            const int t = i >> 6, f = i & 63;
            const float inv = 1.0f / powf(10000.0f, (float)(2 * f) / 128.0f);
            const float ang = (float)((const int*)kin[I_POS])[t] * inv;
            double r = (double)ang * 0.15915494309189533577; r -= floor(r + 0.5); r *= 6.28318530717958647692;
            const double r2 = r * r; double ts = r, tc = 1.0, s = r, c = 1.0;
#pragma unroll 1
            for (int n = 1; n <= 14; ++n) { tc *= -r2 / (double)((2 * n - 1) * (2 * n)); ts *= -r2 / (double)((2 * n) * (2 * n + 1)); c += tc; s += ts; }
            ROPE[2 * i] = (float)c; ROPE[2 * i + 1] = (float)s;
        }
        for (int t = gw; t < NT; t += ngw) row_prep((const float*)kin[I_X] + (size_t)t * DM, XB + (size_t)t * DM, RSTD + t, lane);
        for (int t = gw; t < MEMLEN; t += ngw) row_prep((const float*)kin[I_MEM] + (size_t)t * DM, MB + (size_t)t * DM, RSTDM + t, lane);
    }
    SEAM(0);
    if (PHON(18) && IN(1)) { PTRS();
        for (int u = bid; u < NLAYER * 2 * 8; u += G) {
            const int l = u >> 4, rt = (u >> 3) & 1, ct = u & 7;
            const bf16* Bt = (const bf16*)(ws + WS_WL + (size_t)l * WL_SIZE + WL_WXKVT) + (size_t)ct * 128 * DM;
            f32x4 acc[2][4]; sg_zero(acc);
            sg_tile(lds, MB + (size_t)rt * 128 * DM, DM, Bt, DM, DM, acc, tid);
            bf16* KVM = (bf16*)(ws + WS_KVM) + (size_t)l * MEMLEN * 1024;
            SG_FOREACH(acc, r, c, v, { const int row = rt * 128 + r, col = ct * 128 + c; const float s = RSTDM[row];
                u32x2 o; o.x = pk2(v.x * s, v.y * s); o.y = pk2(v.z * s, v.w * s); *(u32x2*)(KVM + (size_t)row * 1024 + col) = o; });
        }
    }
    SEAM(1);

    for (int l = 0; l < NLAYER; ++l) {
        const int pb = NPH_PRE + l * NPH_LAYER;
        unsigned char* wl = ws + WS_WL + (size_t)l * WL_SIZE;
        if (PHON(0) && IN(pb + 0)) { PTRS();
            const bf16* W1T = (const bf16*)(wl + WL_W1T);
            const float* bgate = (const float*)kin[I_B_GATE] + l * GATEW;
            constexpr int NCT = LD1 / 128;
            for (int u = bid; u < (NT / 128) * NCT; u += G) {
                const int rt = u / NCT, ct = u % NCT;
                f32x4 acc[2][4]; sg_zero(acc);
                sg_tile(lds, XB + (size_t)rt * 128 * DM, DM, W1T + (size_t)ct * 128 * DM, DM, DM, acc, tid);
                SG_FOREACH(acc, r, c, v, { const int row = rt * 128 + r, col = ct * 128 + c; const float s = RSTD[row];
                    float v0 = v.x * s, v1 = v.y * s, v2 = v.z * s, v3 = v.w * s;
                    if (col < C_MV) { const f32x4 cs = *(const f32x4*)(ROPE + ((size_t)row * 64 + ((col & 127) >> 1)) * 2);
                        const float a0 = v0 * cs.x - v1 * cs.y, a1 = v1 * cs.x + v0 * cs.y, a2 = v2 * cs.z - v3 * cs.w, a3 = v3 * cs.z + v2 * cs.w; v0 = a0; v1 = a1; v2 = a2; v3 = a3; }
                    else if (col >= C_GATE) { const f32x4 b = *(const f32x4*)(bgate + col - C_GATE); v0 = sigmoidf_(v0 + b.x); v1 = sigmoidf_(v1 + b.y); v2 = sigmoidf_(v2 + b.z); v3 = sigmoidf_(v3 + b.w); }
                    u32x2 o; o.x = pk2(v0, v1); o.y = pk2(v2, v3); *(u32x2*)(P1 + (size_t)row * LD1 + col) = o; });
            }
        }
        SEAM(pb + 0);
        if (PHON(1) && IN(pb + 1)) { PTRS();
            for (int u = bid; u < 8 * 32; u += G) {
                const int h = u >> 5, blk = u & 31, d = tid & 127, part = tid >> 7;
                float s = 0.f;
                for (int r = 0; r < 64; ++r) s += bf2f(P1[(size_t)(blk * 256 + part * 64 + r) * LD1 + C_MK + h * 128 + d]);
                LAS float* red = (LAS float*)lds;
                __syncthreads(); red[tid] = s; __syncthreads();
                if (tid < 128) KMEAN[(h * 32 + blk) * 128 + tid] = (red[tid] + red[tid + 128] + red[tid + 256] + red[tid + 384]) * (1.0f / 256.0f);
            }
            __syncthreads();
            {
                LAS float* sb = (LAS float*)lds;
                LAS float* sq = (LAS float*)(lds + 32768);
                LAS float* sk = (LAS float*)(lds + 32768 + 33792);
                LAS bf16* sv = (LAS bf16*)(lds + 32768 + 2 * 33792);
                LAS float* sg = (LAS float*)(lds + 32768 + 2 * 33792 + 32768);
                LAS float* sdl = (LAS float*)(lds + 32768 + 2 * 33792 + 32768 + 4096);
                const float* wdec = (const float*)kin[I_W_GLA_DECAY] + (size_t)l * 16 * 512;
                const float* bdec = (const float*)kin[I_B_GLA_DECAY] + l * 512;
                for (int u = bid; u < 4 * 128; u += G) {
                    const int h = u >> 7, ch = u & 127, t0 = ch * 64;
                    __syncthreads();
                    for (int i = tid; i < 64 * 16; i += 512) sg[i] = bf2f(P1[(size_t)(t0 + (i >> 4)) * LD1 + C_GLOW + (i & 15)]);
                    for (int i = tid; i < 64 * 32; i += 512) { const int c = i >> 5, e8 = i & 31; *(LAS u32x4*)(sv + c * 256 + e8 * 8) = *(const u32x4*)(P1 + (size_t)(t0 + c) * LD1 + C_GV + h * 256 + e8 * 8); }
                    __syncthreads();
                    if (tid < 128) {
                        const int d = tid; float w[16];
#pragma unroll
                        for (int r = 0; r < 16; ++r) w[r] = wdec[r * 512 + h * 128 + d];
                        const float b0 = bdec[h * 128 + d]; float cum = 0.f;
                        for (int c = 0; c < 64; ++c) { float z = b0;
#pragma unroll
                            for (int r = 0; r < 16; ++r) z += sg[c * 16 + r] * w[r];
                            const float ls = fminf(z, 0.f) - log1pf(__expf(-fabsf(z)));
                            cum += ls * (1.0f / 16.0f); sb[c * 128 + d] = cum; }
                        GDEC[u * 128 + d] = __expf(cum); sdl[d] = __expf(cum);
                    }
                    __syncthreads();
                    for (int i = tid; i < 64 * 128; i += 512) { const int c = i >> 7, d = i & 127; const float b = sb[i];
                        const float q = bf2f(P1[(size_t)(t0 + c) * LD1 + C_GQ + h * 128 + d]) * 0.08838834764831845f * __expf(b);
                        const float k = bf2f(P1[(size_t)(t0 + c) * LD1 + C_GK + h * 128 + d]) * __expf(-b);
                        sq[c * 132 + d] = q; sk[c * 132 + d] = k; QDEC[(size_t)(t0 + c) * 512 + h * 128 + d] = (bf16)(pk2(q, 0.f) & 0xffffu); }
                    __syncthreads();
                    { const int c = tid >> 3, jg = tid & 7; float at[8];
#pragma unroll
                        for (int jj = 0; jj < 8; ++jj) at[jj] = 0.f;
                        for (int d = 0; d < 128; d += 4) { const f32x4 qv = *(const LAS f32x4*)(sq + c * 132 + d);
#pragma unroll
                            for (int jj = 0; jj < 8; ++jj) { const f32x4 kv = *(const LAS f32x4*)(sk + (jg + 8 * jj) * 132 + d); at[jj] += (qv.x * kv.x + qv.y * kv.y) + (qv.z * kv.z + qv.w * kv.w); } }
#pragma unroll
                        for (int jj = 0; jj < 8; ++jj) { const int j = jg + 8 * jj; sb[c * 64 + j] = (j <= c) ? at[jj] : 0.f; } }
                    __syncthreads();
                    { const int c = tid >> 3, e0 = (tid & 7) * 32; float o[32];
#pragma unroll
                        for (int i = 0; i < 32; ++i) o[i] = 0.f;
                        for (int j = 0; j <= c; ++j) { const float aw = sb[c * 64 + j];
#pragma unroll
                            for (int q4 = 0; q4 < 4; ++q4) { const u32x4 vv = *(const LAS u32x4*)(sv + j * 256 + e0 + q4 * 8);
                                o[q4 * 8 + 0] += aw * bflo(vv.x); o[q4 * 8 + 1] += aw * bfhi(vv.x); o[q4 * 8 + 2] += aw * bflo(vv.y); o[q4 * 8 + 3] += aw * bfhi(vv.y);
                                o[q4 * 8 + 4] += aw * bflo(vv.z); o[q4 * 8 + 5] += aw * bfhi(vv.z); o[q4 * 8 + 6] += aw * bflo(vv.w); o[q4 * 8 + 7] += aw * bfhi(vv.w); } }
                        float* op = OINTRA + (size_t)(t0 + c) * 1024 + h * 256 + e0;
#pragma unroll
                        for (int i = 0; i < 32; i += 4) *(f32x4*)(op + i) = (f32x4){o[i], o[i + 1], o[i + 2], o[i + 3]}; }
                    { const int d0 = (tid >> 5) * 8, e0 = (tid & 31) * 8; float kv[8][8];
#pragma unroll
                        for (int i = 0; i < 8; ++i)
#pragma unroll
                            for (int j = 0; j < 8; ++j) kv[i][j] = 0.f;
                        for (int c = 0; c < 64; ++c) { const f32x4 k0 = *(const LAS f32x4*)(sk + c * 132 + d0), k1 = *(const LAS f32x4*)(sk + c * 132 + d0 + 4);
                            const u32x4 vv = *(const LAS u32x4*)(sv + c * 256 + e0);
                            const float kk[8] = {k0.x, k0.y, k0.z, k0.w, k1.x, k1.y, k1.z, k1.w};
                            const float ve[8] = {bflo(vv.x), bfhi(vv.x), bflo(vv.y), bfhi(vv.y), bflo(vv.z), bfhi(vv.z), bflo(vv.w), bfhi(vv.w)};
#pragma unroll
                            for (int i = 0; i < 8; ++i)
#pragma unroll
                                for (int j = 0; j < 8; ++j) kv[i][j] += kk[i] * ve[j]; }
#pragma unroll
                        for (int i = 0; i < 8; ++i) { const float dl = sdl[d0 + i];
                            float* gp = GKV + ((size_t)u * 128 + d0 + i) * 256 + e0;
                            *(f32x4*)gp = (f32x4){kv[i][0] * dl, kv[i][1] * dl, kv[i][2] * dl, kv[i][3] * dl}; *(f32x4*)(gp + 4) = (f32x4){kv[i][4] * dl, kv[i][5] * dl, kv[i][6] * dl, kv[i][7] * dl}; } }
                }
            }
            for (int i = gt; i < NT * 128; i += ngt) {
                const int t = i >> 7, c8 = (i & 127) * 8, w = 2 << (c8 >> 8);
                const int start = (t + 1 - w) > 0 ? (t + 1 - w) : 0; float s[8];
#pragma unroll
                for (int j = 0; j < 8; ++j) s[j] = 0.f;
                for (int r = start; r <= t; ++r) { const u32x4 vv = *(const u32x4*)(P1 + (size_t)r * LD1 + C_PU + c8);
                    s[0] += bflo(vv.x); s[1] += bfhi(vv.x); s[2] += bflo(vv.y); s[3] += bfhi(vv.y); s[4] += bflo(vv.z); s[5] += bfhi(vv.z); s[6] += bflo(vv.w); s[7] += bfhi(vv.w); }
                const u32x4 uu = *(const u32x4*)(P1 + (size_t)t * LD1 + C_PU + c8); const float ic = 1.0f / (float)(t + 1 - start);
                u32x4 o; o.x = pk2(s[0] * ic - bflo(uu.x), s[1] * ic - bfhi(uu.x)); o.y = pk2(s[2] * ic - bflo(uu.y), s[3] * ic - bfhi(uu.y));
                o.z = pk2(s[4] * ic - bflo(uu.z), s[5] * ic - bfhi(uu.z)); o.w = pk2(s[6] * ic - bflo(uu.w), s[7] * ic - bfhi(uu.w));
                *(u32x4*)(MIXED + (size_t)t * 1024 + c8) = o;
            }
        }
        SEAM(pb + 1);
        if (PHON(2) && IN(pb + 2)) { PTRS();
            for (int i = gt; i < 4 * 128 * 256; i += ngt) {
                const int h = i >> 15, de = i & 32767, d = de >> 8; float s = 0.f;
                float* p = GKV + (size_t)h * 128 * 32768 + de; const float* dc = GDEC + h * 128 * 128 + d;
#pragma unroll 8
                for (int n = 0; n < 128; ++n) { const float kv = p[(size_t)n * 32768]; const float dl = dc[n * 128]; p[(size_t)n * 32768] = s; s = dl * s + kv; }
            }
            {
                const float* pscale = (const float*)kin[I_POOL_SCALE] + l * 1024;
                for (int u = bid; u < 64 * 4 * 2; u += G) {
                    const int rt = u >> 3, g = (u >> 1) & 3, ct = u & 1;
                    f32x4 acc[2][4]; sg_zero(acc);
                    sg_tile(lds, MIXED + (size_t)rt * 128 * 1024 + g * 256, 1024, (const bf16*)(wl + WL_WPOOLT) + (size_t)g * 65536 + (size_t)ct * 128 * 256, 256, 256, acc, tid);
                    SG_FOREACH(acc, r, c, v, { const int row = rt * 128 + r, col = g * 256 + ct * 128 + c; const f32x4 ps = *(const f32x4*)(pscale + col);
                        u32x2 o; o.x = pk2(v.x * ps.x, v.y * ps.y); o.y = pk2(v.z * ps.z, v.w * ps.w); *(u32x2*)(OPOOL + (size_t)row * 1024 + col) = o; });
                }
                __syncthreads();
            }
            {
                LAS float* qs = (LAS float*)(lds + wave * 4608);
                LAS float* ps = (LAS float*)(lds + wave * 4608 + 512);
                for (int it = gw; it < NT * 8; it += ngw) {
                    const int t = it >> 3, h = it & 7, own = t >> 8;
                    { const unsigned w = *(const unsigned*)(P1 + (size_t)t * LD1 + C_MQ + h * 128 + 2 * lane); qs[2 * lane] = bflo(w); qs[2 * lane + 1] = bfhi(w); }
                    asm volatile("s_waitcnt lgkmcnt(0)" ::: "memory");
                    float g = -3.0e38f;
                    if (lane < 32 && lane < own) { g = 0.f; const float* km = KMEAN + (h * 32 + lane) * 128;
                        for (int d = 0; d < 128; d += 4) { const f32x4 kv = *(const f32x4*)(km + d); const f32x4 qv = *(const LAS f32x4*)(qs + d); g += (qv.x * kv.x + qv.y * kv.y) + (qv.z * kv.z + qv.w * kv.w); } }
                    int blk[4]; const int nsel = own < 3 ? own : 3;
#pragma unroll
                    for (int s = 0; s < 3; ++s) { float v = g; int idx = lane;
#pragma unroll
                        for (int o = 32; o >= 1; o >>= 1) { const float ov = __shfl_xor(v, o); const int oi = __shfl_xor(idx, o); if (ov > v || (ov == v && oi < idx)) { v = ov; idx = oi; } }
                        blk[s] = __builtin_amdgcn_readfirstlane(idx); if (lane == blk[s]) g = -3.0e38f; }
                    blk[3] = own;
                    float sc[4][4]; float mx = -3.0e38f;
#pragma unroll
                    for (int bi = 0; bi < 4; ++bi) {
                        const bool valid = (bi == 3) || (bi < nsel);
#pragma unroll
                        for (int i = 0; i < 4; ++i) { sc[bi][i] = -3.0e38f;
                            if (valid) { const int key = blk[bi] * 256 + lane + 64 * i; const bf16* kp = P1 + (size_t)key * LD1 + C_MK + h * 128; float dsum = 0.f;
                                for (int d = 0; d < 128; d += 8) { const u32x4 kv = *(const u32x4*)(kp + d); const f32x4 q0 = *(const LAS f32x4*)(qs + d), q1 = *(const LAS f32x4*)(qs + d + 4);
                                    dsum += (q0.x * bflo(kv.x) + q0.y * bfhi(kv.x)) + (q0.z * bflo(kv.y) + q0.w * bfhi(kv.y)) + (q1.x * bflo(kv.z) + q1.y * bfhi(kv.z)) + (q1.z * bflo(kv.w) + q1.w * bfhi(kv.w)); }
                                if (bi < 3 || key <= t) sc[bi][i] = dsum * 0.08838834764831845f; }
                            mx = fmaxf(mx, sc[bi][i]); } }
                    mx = wave_max(mx); float sum = 0.f;
#pragma unroll
                    for (int bi = 0; bi < 4; ++bi)
#pragma unroll
                        for (int i = 0; i < 4; ++i) { const float p = (sc[bi][i] > -1.0e38f) ? __expf(sc[bi][i] - mx) : 0.f; sc[bi][i] = p; sum += p; }
                    sum = wave_sum(sum); const float inv = 1.0f / sum;
#pragma unroll
                    for (int bi = 0; bi < 4; ++bi)
#pragma unroll
                        for (int i = 0; i < 4; ++i) ps[bi * 256 + lane + 64 * i] = sc[bi][i] * inv;
                    asm volatile("s_waitcnt lgkmcnt(0)" ::: "memory");
                    float o0 = 0.f, o1 = 0.f;
#pragma unroll
                    for (int bi = 0; bi < 4; ++bi) {
                        const bool valid = (bi == 3) || (bi < nsel);
                        if (valid) { const bf16* vp = P1 + (size_t)(blk[bi] * 256) * LD1 + C_MV + h * 128 + 2 * lane; const int nk = (bi == 3) ? (t - own * 256 + 1) : 256;
#pragma unroll 4
                            for (int k = 0; k < nk; ++k) { const float p = ps[bi * 256 + k]; const unsigned w = *(const unsigned*)(vp + (size_t)k * LD1); o0 += p * bflo(w); o1 += p * bfhi(w); } } }
                    *(unsigned*)(OMOBA + (size_t)t * 1024 + h * 128 + 2 * lane) = pk2(o0, o1);
                }
            }
        }
        SEAM(pb + 2);
        if (PHON(3) && IN(pb + 3)) { PTRS();
            LAS float* sq = (LAS float*)lds;
            LAS float* ss = (LAS float*)(lds + 33792);
            const float* gnorm = (const float*)kin[I_GLA_NORM] + l * 256;
            for (int u = bid; u < 4 * 128; u += G) {
                const int h = u >> 7, ch = u & 127, t0 = ch * 64; const int c = tid >> 3, eg = tid & 7;
                __syncthreads();
                for (int i = tid; i < 64 * 128; i += 512) sq[(i >> 7) * 132 + (i & 127)] = bf2f(QDEC[(size_t)(t0 + (i >> 7)) * 512 + h * 128 + (i & 127)]);
                float o[2][16];
#pragma unroll
                for (int hf = 0; hf < 2; ++hf) {
                    __syncthreads();
                    for (int i = tid; i < 128 * 32; i += 512) { const int d = i >> 5, e4 = (i & 31) * 4; *(LAS f32x4*)(ss + d * 128 + e4) = *(const f32x4*)(GKV + ((size_t)u * 128 + d) * 256 + hf * 128 + e4); }
                    __syncthreads();
                    const float* oi = OINTRA + (size_t)(t0 + c) * 1024 + h * 256 + hf * 128 + eg * 16;
#pragma unroll
                    for (int i = 0; i < 16; i += 4) { const f32x4 v = *(const f32x4*)(oi + i); o[hf][i] = v.x; o[hf][i + 1] = v.y; o[hf][i + 2] = v.z; o[hf][i + 3] = v.w; }
                    for (int d = 0; d < 128; ++d) { const float qv = sq[c * 132 + d];
#pragma unroll
                        for (int i = 0; i < 16; i += 4) { const f32x4 sv4 = *(const LAS f32x4*)(ss + d * 128 + eg * 16 + i); o[hf][i] += qv * sv4.x; o[hf][i + 1] += qv * sv4.y; o[hf][i + 2] += qv * sv4.z; o[hf][i + 3] += qv * sv4.w; } }
                }
                float sqs = 0.f;
#pragma unroll
                for (int hf = 0; hf < 2; ++hf)
#pragma unroll
                    for (int i = 0; i < 16; ++i) sqs += o[hf][i] * o[hf][i];
                sqs += __shfl_xor(sqs, 1); sqs += __shfl_xor(sqs, 2); sqs += __shfl_xor(sqs, 4);
                const float rs = 1.0f / sqrtf(sqs * (1.0f / 256.0f) + EPS);
#pragma unroll
                for (int hf = 0; hf < 2; ++hf) { const int e0 = hf * 128 + eg * 16; const bf16* grp = P1 + (size_t)(t0 + c) * LD1 + C_GR + h * 256 + e0; unsigned ow[8];
#pragma unroll
                    for (int i = 0; i < 16; i += 2) { const unsigned gw2 = *(const unsigned*)(grp + i); const float g0 = bflo(gw2), g1 = bfhi(gw2);
                        const float y0 = o[hf][i] * rs * gnorm[e0 + i] * (g0 * sigmoidf_(g0)), y1 = o[hf][i + 1] * rs * gnorm[e0 + i + 1] * (g1 * sigmoidf_(g1)); ow[i >> 1] = pk2(y0, y1); }
                    bf16* op = OGLA + (size_t)(t0 + c) * 1024 + h * 256 + e0;
                    *(u32x4*)op = (u32x4){ow[0], ow[1], ow[2], ow[3]}; *(u32x4*)(op + 8) = (u32x4){ow[4], ow[5], ow[6], ow[7]}; }
            }
        }
        SEAM(pb + 3);
        if (PHON(4) && IN(pb + 4)) { PTRS();
            for (int u = bid; u < 64 * 16; u += G) {
                const int rt = u >> 4, ct = u & 15;
                f32x4 macc[2][4]; sg_zero(macc);
#pragma unroll 1
                for (int n = 0; n < 3; ++n) {
                    const bf16* An = (n == 0) ? OMOBA : (n == 1) ? OGLA : OPOOL;
                    f32x4 acc[2][4]; sg_zero(acc);
                    sg_tile(lds, An + (size_t)rt * 128 * 1024, 1024, (const bf16*)(wl + WL_WBRT) + (size_t)n * DM * 1024 + (size_t)ct * 128 * 1024, 1024, 1024, acc, tid);
                    const int lw = tid >> 6;
#pragma unroll
                    for (int mt = 0; mt < 2; ++mt)
#pragma unroll
                        for (int nt = 0; nt < 4; ++nt) { const int row = rt * 128 + (lw >> 1) * 32 + mt * 16 + (lane & 15), col = ct * 128 + (lw & 1) * 64 + nt * 16 + (lane >> 4) * 4;
                            const u32x2 gg = *(const u32x2*)(P1 + (size_t)row * LD1 + C_GATE + n * DM + col);
                            macc[mt][nt].x += bflo(gg.x) * acc[mt][nt].x; macc[mt][nt].y += bfhi(gg.x) * acc[mt][nt].y; macc[mt][nt].z += bflo(gg.y) * acc[mt][nt].z; macc[mt][nt].w += bfhi(gg.y) * acc[mt][nt].w; }
                }
                SG_FOREACH(macc, r, c, v, { const int row = rt * 128 + r, col = ct * 128 + c; u32x2 o; o.x = pk2(v.x, v.y); o.y = pk2(v.z, v.w); *(u32x2*)(MERGED + (size_t)row * DM + col) = o; });
            }
        }
        SEAM(pb + 4);
        if (PHON(5) && IN(pb + 5)) { PTRS();
            const float* xin = (l == 0) ? (const float*)kin[I_X] : XF;
            for (int u = bid; u < 64 * 16; u += G) {
                const int rt = u >> 4, ct = u & 15;
                f32x4 acc[2][4]; sg_zero(acc);
                sg_tile(lds, MERGED + (size_t)rt * 128 * DM, DM, (const bf16*)(wl + WL_WMIXT) + (size_t)ct * 128 * DM, DM, DM, acc, tid);
                SG_FOREACH(acc, r, c, v, { const size_t o = (size_t)(rt * 128 + r) * DM + ct * 128 + c; *(f32x4*)(XF + o) = *(const f32x4*)(xin + o) + v; });
            }
        }
        SEAM(pb + 5);
        if (PHON(6) && IN(pb + 6)) { PTRS(); for (int t = gw; t < NT; t += ngw) row_prep(XF + (size_t)t * DM, XB + (size_t)t * DM, RSTD + t, lane); }
        SEAM(pb + 6);
        if (PHON(7) && IN(pb + 7)) { PTRS();
            for (int u = bid; u < 64 * 4; u += G) {
                const int rt = u >> 2, ct = u & 3;
                f32x4 acc[2][4]; sg_zero(acc);
                sg_tile(lds, XB + (size_t)rt * 128 * DM, DM, (const bf16*)(wl + WL_WXQT) + (size_t)ct * 128 * DM, DM, DM, acc, tid);
                SG_FOREACH(acc, r, c, v, { const int row = rt * 128 + r, col = ct * 128 + c; const float s = RSTD[row];
                    u32x2 o; o.x = pk2(v.x * s, v.y * s); o.y = pk2(v.z * s, v.w * s); *(u32x2*)(XQ + (size_t)row * 512 + col) = o; });
            }
        }
        SEAM(pb + 7);
        if (PHON(8) && IN(pb + 8)) { PTRS();
            LAS float* qs = (LAS float*)(lds + wave * 2048);
            LAS float* ps = (LAS float*)(lds + wave * 2048 + 512);
            const bf16* KVM = (const bf16*)(ws + WS_KVM) + (size_t)l * MEMLEN * 1024;
            for (int it = gw; it < NT * 4; it += ngw) {
                const int t = it >> 2, h = it & 3;
                { const unsigned w = *(const unsigned*)(XQ + (size_t)t * 512 + h * 128 + 2 * lane); qs[2 * lane] = bflo(w); qs[2 * lane + 1] = bfhi(w); }
                asm volatile("s_waitcnt lgkmcnt(0)" ::: "memory");
                float sc[4]; float mx = -3.0e38f;
#pragma unroll
                for (int i = 0; i < 4; ++i) { const bf16* kp = KVM + (size_t)(lane + 64 * i) * 1024 + h * 128; float dsum = 0.f;
                    for (int d = 0; d < 128; d += 8) { const u32x4 kv = *(const u32x4*)(kp + d); const f32x4 q0 = *(const LAS f32x4*)(qs + d), q1 = *(const LAS f32x4*)(qs + d + 4);
                        dsum += (q0.x * bflo(kv.x) + q0.y * bfhi(kv.x)) + (q0.z * bflo(kv.y) + q0.w * bfhi(kv.y)) + (q1.x * bflo(kv.z) + q1.y * bfhi(kv.z)) + (q1.z * bflo(kv.w) + q1.w * bfhi(kv.w)); }
                    sc[i] = dsum * 0.08838834764831845f; mx = fmaxf(mx, sc[i]); }
                mx = wave_max(mx); float sum = 0.f;
#pragma unroll
                for (int i = 0; i < 4; ++i) { sc[i] = __expf(sc[i] - mx); sum += sc[i]; }
                sum = wave_sum(sum); const float inv = 1.0f / sum;
#pragma unroll
                for (int i = 0; i < 4; ++i) ps[lane + 64 * i] = sc[i] * inv;
                asm volatile("s_waitcnt lgkmcnt(0)" ::: "memory");
                float o0 = 0.f, o1 = 0.f; const bf16* vp = KVM + 512 + h * 128 + 2 * lane;
#pragma unroll 4
                for (int k = 0; k < 256; ++k) { const float p = ps[k]; const unsigned w = *(const unsigned*)(vp + (size_t)k * 1024); o0 += p * bflo(w); o1 += p * bfhi(w); }
                *(unsigned*)(XO + (size_t)t * 512 + h * 128 + 2 * lane) = pk2(o0, o1);
            }
        }
        SEAM(pb + 8);
        if (PHON(9) && IN(pb + 9)) { PTRS();
            for (int u = bid; u < 64 * 16; u += G) {
                const int rt = u >> 4, ct = u & 15;
                f32x4 acc[2][4]; sg_zero(acc);
                sg_tile(lds, XO + (size_t)rt * 128 * 512, 512, (const bf16*)(wl + WL_WXOT) + (size_t)ct * 128 * 512, 512, 512, acc, tid);
                SG_FOREACH(acc, r, c, v, { const size_t o = (size_t)(rt * 128 + r) * DM + ct * 128 + c; *(f32x4*)(XF + o) = *(const f32x4*)(XF + o) + v; });
            }
        }
        SEAM(pb + 9);
        if (PHON(10) && IN(pb + 10)) { PTRS(); for (int t = gw; t < NT; t += ngw) row_prep(XF + (size_t)t * DM, XB + (size_t)t * DM, RSTD + t, lane); }
        SEAM(pb + 10);
        if (PHON(11) && IN(pb + 11)) { PTRS();
            const float* brg = (const float*)kin[I_B_RG] + l * 8; const float* bre = (const float*)kin[I_B_RE] + l * 64;
            for (int u = bid; u < 64; u += G) {
                f32x4 acc[2][4]; sg_zero(acc);
                sg_tile(lds, XB + (size_t)u * 128 * DM, DM, (const bf16*)(wl + WL_WRT), DM, DM, acc, tid);
                SG_FOREACH(acc, r, c, v, { const int row = u * 128 + r; const float s = RSTD[row]; f32x4 o;
                    o.x = v.x * s + rbias(brg, bre, c); o.y = v.y * s + rbias(brg, bre, c + 1); o.z = v.z * s + rbias(brg, bre, c + 2); o.w = v.w * s + rbias(brg, bre, c + 3);
                    *(f32x4*)(LOGITS + (size_t)row * 128 + c) = o; });
            }
        }
        SEAM(pb + 11);
        if (PHON(12) && IN(pb + 12)) { PTRS();
            for (int t = gt; t < NT; t += ngt) {
                const float* lg = LOGITS + (size_t)t * 128; float gl[8]; float gmax = -3.0e38f; int gi = 0;
#pragma unroll
                for (int j = 0; j < 8; ++j) { gl[j] = lg[j]; if (gl[j] > gmax) { gmax = gl[j]; gi = j; } }
                float gs = 0.f;
#pragma unroll
                for (int j = 0; j < 8; ++j) gs += __expf(gl[j] - gmax);
                const float gwt = 1.0f / gs;
                float el[8]; float m1 = -3.0e38f; int i1 = 0;
#pragma unroll
                for (int j = 0; j < 8; ++j) { el[j] = lg[8 + gi * 8 + j]; if (el[j] > m1) { m1 = el[j]; i1 = j; } }
                float m2 = -3.0e38f; int i2 = 0;
#pragma unroll
                for (int j = 0; j < 8; ++j) if (j != i1 && el[j] > m2) { m2 = el[j]; i2 = j; }
                const float p2 = __expf(m2 - m1);
                const float w1 = gwt / (1.0f + p2), w2 = gwt * p2 / (1.0f + p2);
                const int e1 = gi * 8 + i1, e2 = gi * 8 + i2;
                ROUTE[RT_EXP + 2 * t] = e1; ROUTE[RT_EXP + 2 * t + 1] = e2;
                ((float*)ROUTE)[RT_WGT + 2 * t] = w1; ((float*)ROUTE)[RT_WGT + 2 * t + 1] = w2;
            }
        }
        SEAM(pb + 12);
        LAS int* mstart = (LAS int*)(lds + MISC_OFF - 1024);
        LAS int* mtile = (LAS int*)(lds + MISC_OFF - 512);
        LAS int* mcnt = (LAS int*)(lds + MISC_OFF - 1536);
#define MOE_TABLES() do { __syncthreads(); if (tid == 0) { const int* cnt_ = ROUTE + RT_CNT + l * 64; int s_ = 0, tt_ = 0; for (int e_ = 0; e_ < NEXP; ++e_) { const int c_ = __hip_atomic_load(cnt_ + e_, __ATOMIC_RELAXED, __HIP_MEMORY_SCOPE_AGENT); \
            const int nt_ = (c_ + TMOE - 1) / TMOE; mstart[e_] = s_; mtile[e_] = tt_; mcnt[e_] = c_; s_ += nt_ * TMOE; tt_ += nt_; } mstart[NEXP] = s_; mtile[NEXP] = tt_; } __syncthreads(); } while (0)
        if (PHON(13) && IN(pb + 13)) { PTRS();
            LAS int* wc = (LAS int*)lds;
            for (int e = bid; e < NEXP; e += G) {
                int v[32]; int c = 0;
#pragma unroll
                for (int j = 0; j < 32; ++j) { v[j] = ROUTE[RT_EXP + wave * 2048 + j * 64 + lane]; c += __popcll(__ballot(v[j] == e)); }
                __syncthreads(); if (lane == 0) wc[wave] = c; __syncthreads();
                int base = 0, tot = 0;
#pragma unroll
                for (int w = 0; w < 8; ++w) { const int x = wc[w]; tot += x; if (w < wave) base += x; }
#pragma unroll
                for (int j = 0; j < 32; ++j) { const unsigned long long m = __ballot(v[j] == e);
                    if (v[j] == e) { const int rk = base + __popcll(m & ((1ull << lane) - 1ull)); const int idx = wave * 2048 + j * 64 + lane; ROUTE[RT_RANK + idx] = rk; TOKOF[e * NT + rk] = idx >> 1; }
                    base += __popcll(m); }
                if (tid == 0) ROUTE[RT_CNT + l * 64 + e] = tot;
            }
        }
        SEAM(pb + 13);
        if (PHON(14) && IN(pb + 14)) { PTRS();
            MOE_TABLES();
            const int ntile = mtile[NEXP];
            for (int u = bid; u < ntile * 8; u += G) {
                const int rtg = u >> 3, ct = u & 7; int e = 0;
                for (int j = 1; j < NEXP; ++j) if (mtile[j] <= rtg) e = j;
                const int row0 = mstart[e] + (rtg - mtile[e]) * TMOE;
                f32x4 acc[2][4]; sg_zero(acc);
                const int rk0 = (rtg - mtile[e]) * TMOE, ce = mcnt[e];
                { const int rk = rk0 + (tid >> 2); const int tok = rk < ce ? TOKOF[e * NT + rk] : 0;
                  sg_tile_rows(lds, XB + (size_t)tok * DM, (const bf16*)(wl + WL_W13T) + (size_t)e * 1024 * DM + (size_t)(ct * 128 + (tid >> 2)) * DM, DM, acc, tid); }
                SG_FOREACH(acc, r, c, v, { const int row = row0 + r, col = ct * 128 + c; const int rk = rk0 + r; const float s = RSTD[rk < ce ? TOKOF[e * NT + rk] : 0];
                    const float g0 = v.x * s, u0 = v.y * s, g1 = v.z * s, u1 = v.w * s;
                    *(unsigned*)(ACT + (size_t)row * DFF + (col >> 1)) = pk2(g0 * sigmoidf_(g0) * u0, g1 * sigmoidf_(g1) * u1); });
            }
        }
        SEAM(pb + 14);
        if (PHON(15) && IN(pb + 15)) { PTRS();
            MOE_TABLES();
            const int ntile = mtile[NEXP];
            for (int u = bid; u < ntile * 16; u += G) {
                const int rtg = u >> 4, ct = u & 15; int e = 0;
                for (int j = 1; j < NEXP; ++j) if (mtile[j] <= rtg) e = j;
                const int row0 = mstart[e] + (rtg - mtile[e]) * TMOE;
                f32x4 acc[2][4]; sg_zero(acc);
                sg_tile(lds, ACT + (size_t)row0 * DFF, DFF, (const bf16*)(wl + WL_W2T) + (size_t)e * DM * DFF + (size_t)ct * 128 * DFF, DFF, DFF, acc, tid);
                SG_FOREACH(acc, r, c, v, { u32x2 o; o.x = pk2(v.x, v.y); o.y = pk2(v.z, v.w); *(u32x2*)(YB + (size_t)(row0 + r) * DM + ct * 128 + c) = o; });
            }
        }
        SEAM(pb + 15);
        if (PHON(16) && IN(pb + 16)) { PTRS();
            MOE_TABLES();
            const float* nfin = (const float*)kin[I_NORM_FINAL];
            for (int t = gw; t < NT; t += ngw) {
                const int d0 = mstart[ROUTE[RT_EXP + 2 * t]] + ROUTE[RT_RANK + 2 * t], d1 = mstart[ROUTE[RT_EXP + 2 * t + 1]] + ROUTE[RT_RANK + 2 * t + 1]; const float w0 = ((const float*)ROUTE)[RT_WGT + 2 * t], w1 = ((const float*)ROUTE)[RT_WGT + 2 * t + 1];
                f32x4 v[8]; float ss = 0.f;
#pragma unroll
                for (int j = 0; j < 8; ++j) { v[j] = ((const f32x4*)(XF + (size_t)t * DM))[lane + 64 * j];
                    const u32x2 y0 = ((const u32x2*)(YB + (size_t)d0 * DM))[lane + 64 * j], y1 = ((const u32x2*)(YB + (size_t)d1 * DM))[lane + 64 * j];
                    v[j].x += w0 * bflo(y0.x) + w1 * bflo(y1.x); v[j].y += w0 * bfhi(y0.x) + w1 * bfhi(y1.x); v[j].z += w0 * bflo(y0.y) + w1 * bflo(y1.y); v[j].w += w0 * bfhi(y0.y) + w1 * bfhi(y1.y);
                    ss += (v[j].x * v[j].x + v[j].y * v[j].y) + (v[j].z * v[j].z + v[j].w * v[j].w); }
                ss = wave_sum(ss); const float rs = 1.0f / sqrtf(ss * (1.0f / DM) + EPS);
                if (l == NLAYER - 1) {
#pragma unroll
                    for (int j = 0; j < 8; ++j) { const f32x4 g = ((const f32x4*)nfin)[lane + 64 * j]; ((f32x4*)((float*)kin[28] + (size_t)t * DM))[lane + 64 * j] = (f32x4){v[j].x * rs * g.x, v[j].y * rs * g.y, v[j].z * rs * g.z, v[j].w * rs * g.w}; }
                } else {
#pragma unroll
                    for (int j = 0; j < 8; ++j) { ((f32x4*)(XF + (size_t)t * DM))[lane + 64 * j] = v[j]; u32x2 o; o.x = pk2(v[j].x, v[j].y); o.y = pk2(v[j].z, v[j].w); ((u32x2*)(XB + (size_t)t * DM))[lane + 64 * j] = o; }
                    if (lane == 0) RSTD[t] = rs;
                }
            }
        }
        SEAM(pb + 16);
    }
#if DBG_STOP >= 0
    if (IN(NPH)) { PTRS();
        const unsigned* w = (const unsigned*)(wsl + 2 * MiB); const size_t nw = (WS_END - 2 * MiB) / 4; float* out = (float*)kin[28];
        for (int i = gt; i < NT * DM; i += ngt) { unsigned h = 0u; for (size_t j = (size_t)i; j < nw; j += (size_t)NT * DM) { const size_t b = 2 * MiB + 4 * j; const bool skip = false; if (!skip) h = h * 0x9E3779B1u + w[j]; } out[i] = (float)(h & 0xffffu); }
    }
#endif
#undef IN
#undef SEAM
}
}

extern "C" void kernel_launch(void* const* d_in, const int* in_sizes, int n_in, void* d_out, int out_size, void* d_ws, size_t ws_size, hipStream_t stream) {
    static int grid = 0;
    if (grid == 0) {
        if (n_in != 28 || out_size != NT * DM || ws_size < WS_END) { fprintf(stderr, "kernel_launch: unexpected problem (n_in %d out %d ws %zu need %zu)\n", n_in, out_size, ws_size, (size_t)WS_END); grid = -1; return; }
        int dev = 0, cus = 0, per_cu = 0;
        if (hipGetDevice(&dev) != hipSuccess || hipDeviceGetAttribute(&cus, hipDeviceAttributeMultiprocessorCount, dev) != hipSuccess) { grid = -1; return; }
        if (hipFuncSetAttribute((const void*)mk_fwd, hipFuncAttributeMaxDynamicSharedMemorySize, LDS_BYTES) != hipSuccess) { fprintf(stderr, "kernel_launch: hipFuncSetAttribute failed\n"); grid = -1; return; }
        if (hipOccupancyMaxActiveBlocksPerMultiprocessor(&per_cu, (const void*)mk_fwd, 512, LDS_BYTES) != hipSuccess || per_cu < 1) fprintf(stderr, "kernel_launch: occupancy query reports %d\n", per_cu);
        (void)hipGetLastError();
        grid = cus;
    }
    if (grid < 0) return;
    (void)hipMemsetAsync((char*)d_ws + WS_CTL, 0, CTL_BYTES, stream);
    Args a{};
    for (int i = 0; i < 28; ++i) a.in[i] = d_in[i];
    a.out = (float*)d_out; a.ws = (unsigned char*)d_ws;
#if MK_ONE_LAUNCH
    a.ph_lo = 0; a.ph_hi = NPH;
    hipLaunchKernelGGL(mk_fwd, dim3(grid), dim3(512), LDS_BYTES, stream, a);
#else
#if DBG_STOP >= 0
    for (int p = 0; p <= DBG_STOP; ++p) { a.ph_lo = p; a.ph_hi = p + 1; hipLaunchKernelGGL(mk_fwd, dim3(grid), dim3(512), LDS_BYTES, stream, a); }
    a.ph_lo = NPH; a.ph_hi = NPH + 1; hipLaunchKernelGGL(mk_fwd, dim3(grid), dim3(512), LDS_BYTES, stream, a);
#else
    for (int p = 0; p < NPH; ++p) { a.ph_lo = p; a.ph_hi = p + 1; hipLaunchKernelGGL(mk_fwd, dim3(grid), dim3(512), LDS_BYTES, stream, a); }
#endif
#endif
}
```

```cpp
#include <hip/hip_runtime.h>
#include <cstdio>
#include <cstdint>

#ifndef DBG_STOP
#define DBG_STOP -1
#endif
#ifndef MK_ONE_LAUNCH
#define MK_ONE_LAUNCH 1
#endif

namespace {
#define LAS __attribute__((address_space(3)))
typedef unsigned short bf16;
typedef short bf16x8 __attribute__((ext_vector_type(8)));
typedef float f32x4 __attribute__((ext_vector_type(4)));
typedef unsigned u32x4 __attribute__((ext_vector_type(4)));
typedef unsigned u32x2 __attribute__((ext_vector_type(2)));

constexpr int NT = 8192, DM = 2048, NLAYER = 2, MEMLEN = 256;
constexpr int INW = 7184, GATEW = 6144;
constexpr int C_MQ = 0, C_MK = 1024, C_MV = 2048, C_GQ = 3072, C_GK = 3584, C_GV = 4096, C_GR = 5120, C_PU = 6144, C_GLOW = 7168, C_GATE = 7424;
constexpr int LD1 = C_GATE + GATEW;
constexpr int NEXP = 64, DFF = 512, TMOE = 128, PMAX = 16384 + NEXP * TMOE;
constexpr float EPS = 1e-6f;

constexpr size_t MiB = 1u << 20;
constexpr size_t WS_CTL = 0, CTL_BYTES = 1 * MiB;
constexpr size_t WS_ROPE = 2 * MiB;
constexpr size_t WS_RSTD = 6 * MiB;
constexpr size_t WS_RSTDM = WS_RSTD + 64 * 1024;
constexpr size_t WS_KMEAN = 7 * MiB;
constexpr size_t WS_KVM = 8 * MiB;
constexpr size_t WS_MB = 9 * MiB;
constexpr size_t WS_ROUTE = 10 * MiB;
constexpr size_t WS_GDEC = 11 * MiB;
constexpr size_t WS_LOGITS = 12 * MiB;
constexpr size_t WS_TOKOF = 16 * MiB;
constexpr size_t WS_WL = 32 * MiB;
constexpr size_t WL_W1T = 0;
constexpr size_t WL_WBRT = 56 * MiB;
constexpr size_t WL_WPOOLT = 68 * MiB;
constexpr size_t WL_WMIXT = 69 * MiB;
constexpr size_t WL_WXQT = 77 * MiB;
constexpr size_t WL_WXKVT = 79 * MiB;
constexpr size_t WL_WXOT = 83 * MiB;
constexpr size_t WL_WRT = 85 * MiB;
constexpr size_t WL_W13T = 86 * MiB;
constexpr size_t WL_W2T = 342 * MiB;
constexpr size_t WL_SIZE = 470 * MiB;
constexpr size_t WS_ACTS = WS_WL + 2 * WL_SIZE;
constexpr size_t WS_XF = WS_ACTS;
constexpr size_t WS_XB = WS_XF + 64 * MiB;
constexpr size_t WS_P1 = WS_XB + 32 * MiB;
constexpr size_t WS_OMOBA = WS_P1 + 216 * MiB;
constexpr size_t WS_OGLA = WS_OMOBA + 16 * MiB;
constexpr size_t WS_MIXED = WS_OGLA + 16 * MiB;
constexpr size_t WS_OPOOL = WS_MIXED + 16 * MiB;
constexpr size_t WS_QDEC = WS_OPOOL + 16 * MiB;
constexpr size_t WS_OINTRA = WS_QDEC + 8 * MiB;
constexpr size_t WS_GKV = WS_OINTRA + 32 * MiB;
constexpr size_t WS_MERGED = WS_GKV + 64 * MiB;
constexpr size_t WS_XQ = WS_MERGED + 32 * MiB;
constexpr size_t WS_XO = WS_XQ + 8 * MiB;
constexpr size_t WS_XS = WS_XO + 8 * MiB;
constexpr size_t WS_ACT = WS_XS + 96 * MiB;
constexpr size_t WS_Y = WS_ACT + 24 * MiB;
constexpr size_t WS_END = WS_Y + 96 * MiB;
static_assert((size_t)PMAX * 2048 * 2 <= 96 * MiB && (size_t)LD1 * 2048 * 2 <= 56 * MiB && (size_t)NT * LD1 * 2 <= 216 * MiB, "map");
constexpr int CW_BAR = 4096;
constexpr int CW_CNT = 16384;
constexpr int RT_EXP = 0, RT_RANK = 2 * NT, RT_DEST = 4 * NT, RT_WGT = 6 * NT, RT_CNT = 8 * NT;

constexpr int LDS_BYTES = 147456;
constexpr int MISC_OFF = 147456 - 256;

__device__ __forceinline__ float bflo(unsigned w) { return __uint_as_float(w << 16); }
__device__ __forceinline__ float bfhi(unsigned w) { return __uint_as_float(w & 0xffff0000u); }
__device__ __forceinline__ float bf2f(bf16 b) { return __uint_as_float((unsigned)b << 16); }
__device__ __forceinline__ unsigned pk2(float lo, float hi) { unsigned r; asm("v_cvt_pk_bf16_f32 %0, %1, %2" : "=v"(r) : "v"(lo), "v"(hi)); return r; }
__device__ __forceinline__ float wave_sum(float v) {
#pragma unroll
    for (int o = 1; o < 64; o <<= 1) v += __shfl_xor(v, o);
    return v;
}
__device__ __forceinline__ float wave_max(float v) {
#pragma unroll
    for (int o = 1; o < 64; o <<= 1) v = fmaxf(v, __shfl_xor(v, o));
    return v;
}
__device__ __forceinline__ float sigmoidf_(float x) { return 1.0f / (1.0f + __expf(-x)); }

#define XB_TMO      128
#define XB_XCNT(j)  (256  + 64 * (j))
#define XB_XSUB(j)  (1280 + 64 * (j))
#define XB_XGEN(j)  (2304 + 64 * (j))
#define XB_TOP      3328
#define XB_TOPGEN   3392
#define XCD_BAR_WORDS 3456
#define XB_SPIN_CAP (1u << 18)

__device__ __forceinline__ unsigned xb_ld(unsigned* p)              { return __hip_atomic_load(p, __ATOMIC_RELAXED, __HIP_MEMORY_SCOPE_AGENT); }
__device__ __forceinline__ unsigned xb_add(unsigned* p, unsigned v) { return __hip_atomic_fetch_add(p, v, __ATOMIC_RELAXED, __HIP_MEMORY_SCOPE_AGENT); }
__device__ __forceinline__ unsigned xb_xcc_id() { return (unsigned)__builtin_amdgcn_s_getreg((3 << 11) | 20) & 0xFu; }
#define XB_SPIN(cond, bar) do { unsigned _sp = 0; while (cond) { __builtin_amdgcn_s_sleep(1); \
    if ((++_sp & 255u) == 0u) { if (xb_ld(&(bar)[XB_TMO])) break; if (_sp > XB_SPIN_CAP) { atomicAdd(&(bar)[XB_TMO], 1u); break; } } } } while (0)

struct XcdBarrier { unsigned* bar; unsigned x; volatile LAS unsigned* st; };

__device__ __forceinline__ XcdBarrier xcd_barrier_post(unsigned* bar, volatile LAS unsigned* st) {
    XcdBarrier b; b.bar = bar; b.x = xb_xcc_id(); b.st = st;
    if (threadIdx.x == 0) (void)xb_add(&bar[XB_XCNT(b.x)], 1u);
    return b;
}
__device__ __forceinline__ void xcd_barrier_complete(unsigned* bar, unsigned x, unsigned& nloc, unsigned& nx) {
    const unsigned G = gridDim.x * gridDim.y * gridDim.z;
    unsigned sum, cnt, mine, sp = 0u;
    for (;;) {
        sum = 0u; cnt = 0u; mine = 0u;
#pragma unroll
        for (unsigned j = 0; j < 16; ++j) { const unsigned c = xb_ld(&bar[XB_XCNT(j)]); sum += c; cnt += (c > 0u) ? 1u : 0u; mine = (j == x) ? c : mine; }
        if (sum == G) break;
        __builtin_amdgcn_s_sleep(1);
        if ((++sp & 255u) == 0u) { if (xb_ld(&bar[XB_TMO])) break; if (sp > XB_SPIN_CAP) { atomicAdd(&bar[XB_TMO], 1u); break; } }
    }
    nloc = mine > 0u ? mine : 1u; nx = cnt > 0u ? cnt : 1u;
}
__device__ __forceinline__ void xcd_barrier(const XcdBarrier& b) {
    asm volatile("s_waitcnt vmcnt(0)" ::: "memory");
    __syncthreads();
    if (threadIdx.x == 0) {
        unsigned* bar = b.bar;
        __builtin_amdgcn_s_waitcnt(0);
        unsigned nloc = b.st[0], nx = b.st[1];
        if (nloc == 0u) { xcd_barrier_complete(bar, b.x, nloc, nx); b.st[0] = nloc; b.st[1] = nx; }
        const unsigned old = xb_add(&bar[XB_XSUB(b.x)], 1u);
        const unsigned gen = old / nloc;
        if (old + 1u == (gen + 1u) * nloc) {
            __builtin_amdgcn_fence(__ATOMIC_RELEASE, "agent");
            asm volatile("s_waitcnt vmcnt(0)" ::: "memory");
            const unsigned og = xb_add(&bar[XB_TOP], 1u);
            const unsigned tg = og / nx;
            if (og + 1u == (tg + 1u) * nx) xb_add(&bar[XB_TOPGEN], 1u);
            else XB_SPIN(xb_ld(&bar[XB_TOPGEN]) == tg, bar);
            __builtin_amdgcn_fence(__ATOMIC_ACQUIRE, "agent");
            xb_add(&bar[XB_XGEN(b.x)], 1u);
            asm volatile("s_waitcnt vmcnt(0)" ::: "memory");
        } else {
            XB_SPIN(xb_ld(&bar[XB_XGEN(b.x)]) == gen, bar);
            __builtin_amdgcn_fence(__ATOMIC_ACQUIRE, "agent");
            asm volatile("s_waitcnt vmcnt(0)" ::: "memory");
        }
    }
    __syncthreads();
}

constexpr int SG_LDS = 2 * 128 * 80;
__device__ __forceinline__ void sg_tile_rows(LAS unsigned char* lds, const bf16* __restrict__ arow, const bf16* __restrict__ brow, int K, f32x4 (&acc)[2][4], const int tid) {
    const int lane = tid & 63, wid = tid >> 6, wm = wid >> 1, wn = wid & 1;
    const int lr = tid >> 2, lc = tid & 3, fr = lane & 15, fq = lane >> 4;
    const u32x4* ga = (const u32x4*)arow + lc;
    const u32x4* gb = (const u32x4*)brow + lc;
    u32x4 ra = ga[0], rb = gb[0];
#pragma unroll 1
    for (int k0 = 0; k0 < K; k0 += 32) {
        __syncthreads();
        *(LAS u32x4*)(lds + lr * 80 + lc * 16) = ra;
        *(LAS u32x4*)(lds + 10240 + lr * 80 + lc * 16) = rb;
        __syncthreads();
        if (k0 + 32 < K) { ra = ga[(k0 + 32) >> 3]; rb = gb[(k0 + 32) >> 3]; }
        bf16x8 af[2], bfr[4];
#pragma unroll
        for (int mt = 0; mt < 2; ++mt) af[mt] = *(const LAS bf16x8*)(lds + (wm * 32 + mt * 16 + fr) * 80 + fq * 16);
#pragma unroll
        for (int nt = 0; nt < 4; ++nt) bfr[nt] = *(const LAS bf16x8*)(lds + 10240 + (wn * 64 + nt * 16 + fr) * 80 + fq * 16);
#pragma unroll
        for (int mt = 0; mt < 2; ++mt)
#pragma unroll
            for (int nt = 0; nt < 4; ++nt) acc[mt][nt] = __builtin_amdgcn_mfma_f32_16x16x32_bf16(bfr[nt], af[mt], acc[mt][nt], 0, 0, 0);
    }
}
__device__ __forceinline__ void sg_tile(LAS unsigned char* lds, const bf16* __restrict__ A, int lda, const bf16* __restrict__ Bt, int ldb, int K, f32x4 (&acc)[2][4], const int tid) {
    sg_tile_rows(lds, A + (size_t)(tid >> 2) * lda, Bt + (size_t)(tid >> 2) * ldb, K, acc, tid);
}
__device__ __forceinline__ void sg_zero(f32x4 (&acc)[2][4]) {
#pragma unroll
    for (int mt = 0; mt < 2; ++mt)
#pragma unroll
        for (int nt = 0; nt < 4; ++nt) acc[mt][nt] = (f32x4){0.f, 0.f, 0.f, 0.f};
}
#define SG_FOREACH(acc, ROW, COL, V, ...) do { const int _l = tid & 63, _w = tid >> 6; \
    _Pragma("unroll") for (int _mt = 0; _mt < 2; ++_mt) _Pragma("unroll") for (int _nt = 0; _nt < 4; ++_nt) { \
        const int ROW = (_w >> 1) * 32 + _mt * 16 + (_l & 15), COL = (_w & 1) * 64 + _nt * 16 + (_l >> 4) * 4; const f32x4 V = acc[_mt][_nt]; __VA_ARGS__ } } while (0)

struct MapOff { int off; __device__ __forceinline__ int operator()(int c) const { return off + c; } };
struct MapRope { __device__ __forceinline__ int operator()(int c) const { if (c >= 2048) return c; const int d = c & 127; const int j = (d < 64) ? 2 * d : 2 * (d - 64) + 1; return (c & ~127) + j; } };
struct MapIl { int par; __device__ __forceinline__ int operator()(int c) const { return 2 * c + par; } };
template <class Map>
__device__ __forceinline__ void transpose_mat(const float* __restrict__ W, int ldw, int K, int ncols, bf16* WT, int ldt, const float* __restrict__ kscale, Map map, LAS float* scr, int gw, int ngw, int lane) {
    const int nblk = ncols / 32, items = (K / 64) * nblk;
    for (int it = gw; it < items; it += ngw) {
        const int kb = it / nblk, nb = it % nblk, k0 = 64 * kb, n0 = 32 * nb;
#pragma unroll 8
        for (int i = 0; i < 32; ++i) { const int kk = 2 * i + (lane >> 5); float v = W[(size_t)(k0 + kk) * ldw + n0 + (lane & 31)]; if (kscale) v *= kscale[k0 + kk]; scr[kk * 33 + (lane & 31)] = v; }
        asm volatile("s_waitcnt lgkmcnt(0)" ::: "memory");
        const int c = lane & 7;
#pragma unroll
        for (int j = 0; j < 4; ++j) { const int n = (lane >> 3) + 8 * j; const LAS float* s = scr + (8 * c) * 33 + n;
            u32x4 o; o.x = pk2(s[0 * 33], s[1 * 33]); o.y = pk2(s[2 * 33], s[3 * 33]); o.z = pk2(s[4 * 33], s[5 * 33]); o.w = pk2(s[6 * 33], s[7 * 33]);
            *(u32x4*)(WT + (size_t)map(n0 + n) * ldt + k0 + 8 * c) = o; }
        asm volatile("s_waitcnt lgkmcnt(0)" ::: "memory");
    }
}
__device__ __forceinline__ void transpose_small(const float* __restrict__ W, int ldw, int K, int ncols, bf16* WT, int ldt, int row_off, const float* __restrict__ kscale, int gt, int ngt) {
    for (int i = gt; i < K * ncols; i += ngt) { const int n = i / K, k = i % K; float v = W[(size_t)k * ldw + n]; if (kscale) v *= kscale[k]; WT[(size_t)(row_off + n) * ldt + k] = (bf16)(pk2(v, 0.f) & 0xffffu); }
}

__device__ __forceinline__ float rbias(const float* brg, const float* bre, int col) { return col < 8 ? brg[col] : (col < 72 ? bre[col - 8] : 0.f); }
struct Args { const void* in[28]; float* out; unsigned char* ws; int ph_lo, ph_hi; };
enum { I_X = 0, I_MEM, I_POS, I_NORM_MIX, I_W_IN, I_W_GLA_DECAY, I_B_GLA_DECAY, I_GLA_NORM, I_W_POOL, I_POOL_SCALE, I_W_BRANCH, I_W_GATE, I_B_GATE, I_W_MIX_OUT,
       I_NORM_XATTN, I_NORM_MEM, I_W_XQ, I_W_XKV, I_W_XO, I_NORM_MOE, I_W_RG, I_B_RG, I_W_RE, I_B_RE, I_W_EG, I_W_EU, I_W_ED, I_NORM_FINAL };

static_assert(sizeof(Args) == 248 && __builtin_offsetof(Args, out) == 224 && __builtin_offsetof(Args, ws) == 232, "kernarg layout");
constexpr int NPH_PRE = 2, NPH_LAYER = 17, NPH = NPH_PRE + NLAYER * NPH_LAYER;

__device__ __forceinline__ void row_prep(const float* xr, bf16* xb, float* rstd_out, int lane) {
    float ss = 0.f; f32x4 v[8];
#pragma unroll
    for (int j = 0; j < 8; ++j) { v[j] = ((const f32x4*)xr)[lane + 64 * j]; ss += (v[j].x * v[j].x + v[j].y * v[j].y) + (v[j].z * v[j].z + v[j].w * v[j].w); }
    ss = wave_sum(ss);
#pragma unroll
    for (int j = 0; j < 8; ++j) { u32x2 o; o.x = pk2(v[j].x, v[j].y); o.y = pk2(v[j].z, v[j].w); ((u32x2*)xb)[lane + 64 * j] = o; }
    if (lane == 0) *rstd_out = 1.0f / sqrtf(ss * (1.0f / DM) + EPS);
}

#define PTRS() unsigned char* wsl = ws; asm volatile("" : "+s"(wsl)); \
    const void* const* kin = (const void* const*)__builtin_amdgcn_kernarg_segment_ptr(); asm volatile("" : "+s"(kin)); \
    int tid = tid0; asm volatile("" : "+v"(tid)); int bid = bid0; asm volatile("" : "+s"(bid)); \
    const int lane = tid & 63, wave = __builtin_amdgcn_readfirstlane(tid >> 6), G = gridDim.x; \
    const int gw = bid * 8 + wave, ngw = G * 8, gt = bid * 512 + tid, ngt = G * 512; (void)gw; (void)ngw; (void)gt; (void)ngt; (void)lane; (void)kin; \
    float* ROPE = (float*)(wsl + WS_ROPE); \
    float* RSTD = (float*)(wsl + WS_RSTD); \
    float* RSTDM = (float*)(wsl + WS_RSTDM); \
    float* KMEAN = (float*)(wsl + WS_KMEAN); \
    bf16* MB = (bf16*)(wsl + WS_MB); \
    int* ROUTE = (int*)(wsl + WS_ROUTE); \
    float* GDEC = (float*)(wsl + WS_GDEC); \
    float* LOGITS = (float*)(wsl + WS_LOGITS); \
    int* TOKOF = (int*)(wsl + WS_TOKOF); \
    float* XF = (float*)(wsl + WS_XF); \
    bf16* XB = (bf16*)(wsl + WS_XB); \
    bf16* P1 = (bf16*)(wsl + WS_P1); \
    bf16* OMOBA = (bf16*)(wsl + WS_OMOBA); \
    bf16* OGLA = (bf16*)(wsl + WS_OGLA); \
    bf16* MIXED = (bf16*)(wsl + WS_MIXED); \
    bf16* OPOOL = (bf16*)(wsl + WS_OPOOL); \
    bf16* QDEC = (bf16*)(wsl + WS_QDEC); \
    float* OINTRA = (float*)(wsl + WS_OINTRA); \
    float* GKV = (float*)(wsl + WS_GKV); \
    bf16* MERGED = (bf16*)(wsl + WS_MERGED); \
    bf16* XQ = (bf16*)(wsl + WS_XQ); \
    bf16* XO = (bf16*)(wsl + WS_XO); \
    bf16* XS = (bf16*)(wsl + WS_XS); \
    bf16* ACT = (bf16*)(wsl + WS_ACT); \
    bf16* YB = (bf16*)(wsl + WS_Y);
__global__ void __launch_bounds__(512, 2) mk_fwd(Args a) {
    extern __shared__ __attribute__((aligned(16))) unsigned char lds_raw[];
    LAS unsigned char* lds = (LAS unsigned char*)lds_raw;
    const int tid0 = threadIdx.x, bid0 = blockIdx.x;
    unsigned char* ws = a.ws;
    unsigned* ctl = (unsigned*)(ws + WS_CTL);
    volatile LAS unsigned* MISC = (volatile LAS unsigned*)(lds + MISC_OFF);
    if (tid0 < 64) MISC[tid0] = 0u;
    __syncthreads();
    XcdBarrier bar; bar.bar = ctl + CW_BAR; bar.x = 0; bar.st = nullptr;
#if MK_ONE_LAUNCH
    bar = xcd_barrier_post(ctl + CW_BAR, MISC + 8);
#endif
    const int lo = a.ph_lo, hi = a.ph_hi;
#ifndef PH_MASK
#define PH_MASK 0x7ffffu
#endif
#define PHON(j) (((PH_MASK) >> (j)) & 1u)
#define IN(k) (lo <= (k) && (k) < hi)
#define SEAM(k) do { if (IN(k) && IN((k) + 1)) xcd_barrier(bar); } while (0)

    if (PHON(17) && IN(0)) { PTRS();
        LAS float* scr = (LAS float*)(lds + wave * 8448);
        for (int l = 0; l < NLAYER; ++l) {
            unsigned char* wl = ws + WS_WL + (size_t)l * WL_SIZE;
            bf16* W1T = (bf16*)(wl + WL_W1T);
            const float* nmix = (const float*)kin[I_NORM_MIX] + l * DM;
            const float* w_in = (const float*)kin[I_W_IN] + (size_t)l * DM * INW;
            transpose_mat(w_in, INW, DM, 6144, W1T, DM, nmix, MapRope{}, scr, gw, ngw, lane);
            transpose_mat(w_in + 6160, INW, DM, 1024, W1T, DM, nmix, MapOff{C_PU}, scr, gw, ngw, lane);
            transpose_small(w_in + 6144, INW, DM, 16, W1T, DM, C_GLOW, nmix, gt, ngt);
            for (int i = gt; i < (C_GATE - C_GLOW - 16) * DM / 8; i += ngt) ((u32x4*)(W1T + (size_t)(C_GLOW + 16) * DM))[i] = (u32x4){0u, 0u, 0u, 0u};
            transpose_mat((const float*)kin[I_W_GATE] + (size_t)l * DM * GATEW, GATEW, DM, GATEW, W1T, DM, nmix, MapOff{C_GATE}, scr, gw, ngw, lane);
            for (int n = 0; n < 3; ++n)
                transpose_mat((const float*)kin[I_W_BRANCH] + ((size_t)l * 3 + n) * 1024 * DM, DM, 1024, DM, (bf16*)(wl + WL_WBRT) + (size_t)n * DM * 1024, 1024, nullptr, MapOff{0}, scr, gw, ngw, lane);
            for (int g = 0; g < 4; ++g)
                transpose_mat((const float*)kin[I_W_POOL] + ((size_t)l * 4 + g) * 256 * 256, 256, 256, 256, (bf16*)(wl + WL_WPOOLT) + (size_t)g * 256 * 256, 256, nullptr, MapOff{0}, scr, gw, ngw, lane);
            transpose_mat((const float*)kin[I_W_MIX_OUT] + (size_t)l * DM * DM, DM, DM, DM, (bf16*)(wl + WL_WMIXT), DM, nullptr, MapOff{0}, scr, gw, ngw, lane);
            transpose_mat((const float*)kin[I_W_XQ] + (size_t)l * DM * 512, 512, DM, 512, (bf16*)(wl + WL_WXQT), DM, (const float*)kin[I_NORM_XATTN] + l * DM, MapOff{0}, scr, gw, ngw, lane);
            transpose_mat((const float*)kin[I_W_XKV] + (size_t)l * DM * 1024, 1024, DM, 1024, (bf16*)(wl + WL_WXKVT), DM, (const float*)kin[I_NORM_MEM] + l * DM, MapOff{0}, scr, gw, ngw, lane);
            transpose_mat((const float*)kin[I_W_XO] + (size_t)l * 512 * DM, DM, 512, DM, (bf16*)(wl + WL_WXOT), 512, nullptr, MapOff{0}, scr, gw, ngw, lane);
            const float* nmoe = (const float*)kin[I_NORM_MOE] + l * DM;
            bf16* WRT = (bf16*)(wl + WL_WRT);
            transpose_small((const float*)kin[I_W_RG] + (size_t)l * DM * 8, 8, DM, 8, WRT, DM, 0, nmoe, gt, ngt);
            transpose_small((const float*)kin[I_W_RE] + (size_t)l * DM * 64, 64, DM, 64, WRT, DM, 8, nmoe, gt, ngt);
            for (int i = gt; i < (128 - 72) * DM / 8; i += ngt) ((u32x4*)(WRT + (size_t)72 * DM))[i] = (u32x4){0u, 0u, 0u, 0u};
            for (int e = 0; e < NEXP; ++e) {
                bf16* W13 = (bf16*)(wl + WL_W13T) + (size_t)e * 1024 * DM;
                transpose_mat((const float*)kin[I_W_EG] + ((size_t)l * NEXP + e) * DM * DFF, DFF, DM, DFF, W13, DM, nmoe, MapIl{0}, scr, gw, ngw, lane);
                transpose_mat((const float*)kin[I_W_EU] + ((size_t)l * NEXP + e) * DM * DFF, DFF, DM, DFF, W13, DM, nmoe, MapIl{1}, scr, gw, ngw, lane);
                transpose_mat((const float*)kin[I_W_ED] + ((size_t)l * NEXP + e) * DFF * DM, DM, DFF, DM, (bf16*)(wl + WL_W2T) + (size_t)e * DM * DFF, DFF, nullptr, MapOff{0}, scr, gw, ngw, lane);
            }
        }
        for (int i = gt; i < NT * 64; i += ngt) {
            const int t = i >> 6, f = i & 63;
            const float inv = 1.0f / powf(10000.0f, (float)(2 * f) / 128.0f);
            const float ang = (float)((const int*)kin[I_POS])[t] * inv;
            double r = (double)ang * 0.15915494309189533577; r -= floor(r + 0.5); r *= 6.28318530717958647692;
            const double r2 = r * r; double ts = r, tc = 1.0, s = r, c = 1.0;
#pragma unroll 1
            for (int n = 1; n <= 14; ++n) { tc *= -r2 / (double)((2 * n - 1) * (2 * n)); ts *= -r2 / (double)((2 * n) * (2 * n + 1)); c += tc; s += ts; }
            ROPE[2 * i] = (float)c; ROPE[2 * i + 1] = (float)s;
        }
        for (int t = gw; t < NT; t += ngw) row_prep((const float*)kin[I_X] + (size_t)t * DM, XB + (size_t)t * DM, RSTD + t, lane);
        for (int t = gw; t < MEMLEN; t += ngw) row_prep((const float*)kin[I_MEM] + (size_t)t * DM, MB + (size_t)t * DM, RSTDM + t, lane);
    }
    SEAM(0);
    if (PHON(18) && IN(1)) { PTRS();
        for (int u = bid; u < NLAYER * 2 * 8; u += G) {
            const int l = u >> 4, rt = (u >> 3) & 1, ct = u & 7;
            const bf16* Bt = (const bf16*)(ws + WS_WL + (size_t)l * WL_SIZE + WL_WXKVT) + (size_t)ct * 128 * DM;
            f32x4 acc[2][4]; sg_zero(acc);
            sg_tile(lds, MB + (size_t)rt * 128 * DM, DM, Bt, DM, DM, acc, tid);
            bf16* KVM = (bf16*)(ws + WS_KVM) + (size_t)l * MEMLEN * 1024;
            SG_FOREACH(acc, r, c, v, { const int row = rt * 128 + r, col = ct * 128 + c; const float s = RSTDM[row];
                u32x2 o; o.x = pk2(v.x * s, v.y * s); o.y = pk2(v.z * s, v.w * s); *(u32x2*)(KVM + (size_t)row * 1024 + col) = o; });
        }
    }
    SEAM(1);

    for (int l = 0; l < NLAYER; ++l) {
        const int pb = NPH_PRE + l * NPH_LAYER;
        unsigned char* wl = ws + WS_WL + (size_t)l * WL_SIZE;
        if (PHON(0) && IN(pb + 0)) { PTRS();
            const bf16* W1T = (const bf16*)(wl + WL_W1T);
            const float* bgate = (const float*)kin[I_B_GATE] + l * GATEW;
            constexpr int NCT = LD1 / 128;
            for (int u = bid; u < (NT / 128) * NCT; u += G) {
                const int rt = u / NCT, ct = u % NCT;
                f32x4 acc[2][4]; sg_zero(acc);
                sg_tile(lds, XB + (size_t)rt * 128 * DM, DM, W1T + (size_t)ct * 128 * DM, DM, DM, acc, tid);
                SG_FOREACH(acc, r, c, v, { const int row = rt * 128 + r, col = ct * 128 + c; const float s = RSTD[row];
                    float v0 = v.x * s, v1 = v.y * s, v2 = v.z * s, v3 = v.w * s;
                    if (col < C_MV) { const f32x4 cs = *(const f32x4*)(ROPE + ((size_t)row * 64 + ((col & 127) >> 1)) * 2);
                        const float a0 = v0 * cs.x - v1 * cs.y, a1 = v1 * cs.x + v0 * cs.y, a2 = v2 * cs.z - v3 * cs.w, a3 = v3 * cs.z + v2 * cs.w; v0 = a0; v1 = a1; v2 = a2; v3 = a3; }
                    else if (col >= C_GATE) { const f32x4 b = *(const f32x4*)(bgate + col - C_GATE); v0 = sigmoidf_(v0 + b.x); v1 = sigmoidf_(v1 + b.y); v2 = sigmoidf_(v2 + b.z); v3 = sigmoidf_(v3 + b.w); }
                    u32x2 o; o.x = pk2(v0, v1); o.y = pk2(v2, v3); *(u32x2*)(P1 + (size_t)row * LD1 + col) = o; });
            }
        }
        SEAM(pb + 0);
        if (PHON(1) && IN(pb + 1)) { PTRS();
            for (int u = bid; u < 8 * 32; u += G) {
                const int h = u >> 5, blk = u & 31, d = tid & 127, part = tid >> 7;
                float s = 0.f;
                for (int r = 0; r < 64; ++r) s += bf2f(P1[(size_t)(blk * 256 + part * 64 + r) * LD1 + C_MK + h * 128 + d]);
                LAS float* red = (LAS float*)lds;
                __syncthreads(); red[tid] = s; __syncthreads();
                if (tid < 128) KMEAN[(h * 32 + blk) * 128 + tid] = (red[tid] + red[tid + 128] + red[tid + 256] + red[tid + 384]) * (1.0f / 256.0f);
            }
            __syncthreads();
            {
                LAS float* sb = (LAS float*)lds;
                LAS float* sq = (LAS float*)(lds + 32768);
                LAS float* sk = (LAS float*)(lds + 32768 + 33792);
                LAS bf16* sv = (LAS bf16*)(lds + 32768 + 2 * 33792);
                LAS float* sg = (LAS float*)(lds + 32768 + 2 * 33792 + 32768);
                LAS float* sdl = (LAS float*)(lds + 32768 + 2 * 33792 + 32768 + 4096);
                const float* wdec = (const float*)kin[I_W_GLA_DECAY] + (size_t)l * 16 * 512;
                const float* bdec = (const float*)kin[I_B_GLA_DECAY] + l * 512;
                for (int u = bid; u < 4 * 128; u += G) {
                    const int h = u >> 7, ch = u & 127, t0 = ch * 64;
                    __syncthreads();
                    for (int i = tid; i < 64 * 16; i += 512) sg[i] = bf2f(P1[(size_t)(t0 + (i >> 4)) * LD1 + C_GLOW + (i & 15)]);
                    for (int i = tid; i < 64 * 32; i += 512) { const int c = i >> 5, e8 = i & 31; *(LAS u32x4*)(sv + c * 256 + e8 * 8) = *(const u32x4*)(P1 + (size_t)(t0 + c) * LD1 + C_GV + h * 256 + e8 * 8); }
                    __syncthreads();
                    if (tid < 128) {
                        const int d = tid; float w[16];
#pragma unroll
                        for (int r = 0; r < 16; ++r) w[r] = wdec[r * 512 + h * 128 + d];
                        const float b0 = bdec[h * 128 + d]; float cum = 0.f;
                        for (int c = 0; c < 64; ++c) { float z = b0;
#pragma unroll
                            for (int r = 0; r < 16; ++r) z += sg[c * 16 + r] * w[r];
                            const float ls = fminf(z, 0.f) - log1pf(__expf(-fabsf(z)));
                            cum += ls * (1.0f / 16.0f); sb[c * 128 + d] = cum; }
                        GDEC[u * 128 + d] = __expf(cum); sdl[d] = __expf(cum);
                    }
                    __syncthreads();
                    for (int i = tid; i < 64 * 128; i += 512) { const int c = i >> 7, d = i & 127; const float b = sb[i];
                        const float q = bf2f(P1[(size_t)(t0 + c) * LD1 + C_GQ + h * 128 + d]) * 0.08838834764831845f * __expf(b);
                        const float k = bf2f(P1[(size_t)(t0 + c) * LD1 + C_GK + h * 128 + d]) * __expf(-b);
                        sq[c * 132 + d] = q; sk[c * 132 + d] = k; QDEC[(size_t)(t0 + c) * 512 + h * 128 + d] = (bf16)(pk2(q, 0.f) & 0xffffu); }
                    __syncthreads();
                    { const int c = tid >> 3, jg = tid & 7; float at[8];
#pragma unroll
                        for (int jj = 0; jj < 8; ++jj) at[jj] = 0.f;
                        for (int d = 0; d < 128; d += 4) { const f32x4 qv = *(const LAS f32x4*)(sq + c * 132 + d);
#pragma unroll
                            for (int jj = 0; jj < 8; ++jj) { const f32x4 kv = *(const LAS f32x4*)(sk + (jg + 8 * jj) * 132 + d); at[jj] += (qv.x * kv.x + qv.y * kv.y) + (qv.z * kv.z + qv.w * kv.w); } }
#pragma unroll
                        for (int jj = 0; jj < 8; ++jj) { const int j = jg + 8 * jj; sb[c * 64 + j] = (j <= c) ? at[jj] : 0.f; } }
                    __syncthreads();
                    { const int c = tid >> 3, e0 = (tid & 7) * 32; float o[32];
#pragma unroll
                        for (int i = 0; i < 32; ++i) o[i] = 0.f;
                        for (int j = 0; j <= c; ++j) { const float aw = sb[c * 64 + j];
#pragma unroll
                            for (int q4 = 0; q4 < 4; ++q4) { const u32x4 vv = *(const LAS u32x4*)(sv + j * 256 + e0 + q4 * 8);
                                o[q4 * 8 + 0] += aw * bflo(vv.x); o[q4 * 8 + 1] += aw * bfhi(vv.x); o[q4 * 8 + 2] += aw * bflo(vv.y); o[q4 * 8 + 3] += aw * bfhi(vv.y);
                                o[q4 * 8 + 4] += aw * bflo(vv.z); o[q4 * 8 + 5] += aw * bfhi(vv.z); o[q4 * 8 + 6] += aw * bflo(vv.w); o[q4 * 8 + 7] += aw * bfhi(vv.w); } }
                        float* op = OINTRA + (size_t)(t0 + c) * 1024 + h * 256 + e0;
#pragma unroll
                        for (int i = 0; i < 32; i += 4) *(f32x4*)(op + i) = (f32x4){o[i], o[i + 1], o[i + 2], o[i + 3]}; }
                    { const int d0 = (tid >> 5) * 8, e0 = (tid & 31) * 8; float kv[8][8];
#pragma unroll
                        for (int i = 0; i < 8; ++i)
#pragma unroll
                            for (int j = 0; j < 8; ++j) kv[i][j] = 0.f;
                        for (int c = 0; c < 64; ++c) { const f32x4 k0 = *(const LAS f32x4*)(sk + c * 132 + d0), k1 = *(const LAS f32x4*)(sk + c * 132 + d0 + 4);
                            const u32x4 vv = *(const LAS u32x4*)(sv + c * 256 + e0);
                            const float kk[8] = {k0.x, k0.y, k0.z, k0.w, k1.x, k1.y, k1.z, k1.w};
                            const float ve[8] = {bflo(vv.x), bfhi(vv.x), bflo(vv.y), bfhi(vv.y), bflo(vv.z), bfhi(vv.z), bflo(vv.w), bfhi(vv.w)};
#pragma unroll
                            for (int i = 0; i < 8; ++i)
#pragma unroll
                                for (int j = 0; j < 8; ++j) kv[i][j] += kk[i] * ve[j]; }
#pragma unroll
                        for (int i = 0; i < 8; ++i) { const float dl = sdl[d0 + i];
                            float* gp = GKV + ((size_t)u * 128 + d0 + i) * 256 + e0;
                            *(f32x4*)gp = (f32x4){kv[i][0] * dl, kv[i][1] * dl, kv[i][2] * dl, kv[i][3] * dl}; *(f32x4*)(gp + 4) = (f32x4){kv[i][4] * dl, kv[i][5] * dl, kv[i][6] * dl, kv[i][7] * dl}; } }
                }
            }
            for (int i = gt; i < NT * 128; i += ngt) {
                const int t = i >> 7, c8 = (i & 127) * 8, w = 2 << (c8 >> 8);
                const int start = (t + 1 - w) > 0 ? (t + 1 - w) : 0; float s[8];
#pragma unroll
                for (int j = 0; j < 8; ++j) s[j] = 0.f;
                for (int r = start; r <= t; ++r) { const u32x4 vv = *(const u32x4*)(P1 + (size_t)r * LD1 + C_PU + c8);
                    s[0] += bflo(vv.x); s[1] += bfhi(vv.x); s[2] += bflo(vv.y); s[3] += bfhi(vv.y); s[4] += bflo(vv.z); s[5] += bfhi(vv.z); s[6] += bflo(vv.w); s[7] += bfhi(vv.w); }
                const u32x4 uu = *(const u32x4*)(P1 + (size_t)t * LD1 + C_PU + c8); const float ic = 1.0f / (float)(t + 1 - start);
                u32x4 o; o.x = pk2(s[0] * ic - bflo(uu.x), s[1] * ic - bfhi(uu.x)); o.y = pk2(s[2] * ic - bflo(uu.y), s[3] * ic - bfhi(uu.y));
                o.z = pk2(s[4] * ic - bflo(uu.z), s[5] * ic - bfhi(uu.z)); o.w = pk2(s[6] * ic - bflo(uu.w), s[7] * ic - bfhi(uu.w));
                *(u32x4*)(MIXED + (size_t)t * 1024 + c8) = o;
            }
        }
        SEAM(pb + 1);
        if (PHON(2) && IN(pb + 2)) { PTRS();
            for (int i = gt; i < 4 * 128 * 256; i += ngt) {
                const int h = i >> 15, de = i & 32767, d = de >> 8; float s = 0.f;
                float* p = GKV + (size_t)h * 128 * 32768 + de; const float* dc = GDEC + h * 128 * 128 + d;
#pragma unroll 8
                for (int n = 0; n < 128; ++n) { const float kv = p[(size_t)n * 32768]; const float dl = dc[n * 128]; p[(size_t)n * 32768] = s; s = dl * s + kv; }
            }
            {
                const float* pscale = (const float*)kin[I_POOL_SCALE] + l * 1024;
                for (int u = bid; u < 64 * 4 * 2; u += G) {
                    const int rt = u >> 3, g = (u >> 1) & 3, ct = u & 1;
                    f32x4 acc[2][4]; sg_zero(acc);
                    sg_tile(lds, MIXED + (size_t)rt * 128 * 1024 + g * 256, 1024, (const bf16*)(wl + WL_WPOOLT) + (size_t)g * 65536 + (size_t)ct * 128 * 256, 256, 256, acc, tid);
                    SG_FOREACH(acc, r, c, v, { const int row = rt * 128 + r, col = g * 256 + ct * 128 + c; const f32x4 ps = *(const f32x4*)(pscale + col);
                        u32x2 o; o.x = pk2(v.x * ps.x, v.y * ps.y); o.y = pk2(v.z * ps.z, v.w * ps.w); *(u32x2*)(OPOOL + (size_t)row * 1024 + col) = o; });
                }
                __syncthreads();
            }
            {
                LAS float* qs = (LAS float*)(lds + wave * 4608);
                LAS float* ps = (LAS float*)(lds + wave * 4608 + 512);
                for (int it = gw; it < NT * 8; it += ngw) {
                    const int t = it >> 3, h = it & 7, own = t >> 8;
                    { const unsigned w = *(const unsigned*)(P1 + (size_t)t * LD1 + C_MQ + h * 128 + 2 * lane); qs[2 * lane] = bflo(w); qs[2 * lane + 1] = bfhi(w); }
                    asm volatile("s_waitcnt lgkmcnt(0)" ::: "memory");
                    float g = -3.0e38f;
                    if (lane < 32 && lane < own) { g = 0.f; const float* km = KMEAN + (h * 32 + lane) * 128;
                        for (int d = 0; d < 128; d += 4) { const f32x4 kv = *(const f32x4*)(km + d); const f32x4 qv = *(const LAS f32x4*)(qs + d); g += (qv.x * kv.x + qv.y * kv.y) + (qv.z * kv.z + qv.w * kv.w); } }
                    int blk[4]; const int nsel = own < 3 ? own : 3;
#pragma unroll
                    for (int s = 0; s < 3; ++s) { float v = g; int idx = lane;
#pragma unroll
                        for (int o = 32; o >= 1; o >>= 1) { const float ov = __shfl_xor(v, o); const int oi = __shfl_xor(idx, o); if (ov > v || (ov == v && oi < idx)) { v = ov; idx = oi; } }
                        blk[s] = __builtin_amdgcn_readfirstlane(idx); if (lane == blk[s]) g = -3.0e38f; }
                    blk[3] = own;
                    float sc[4][4]; float mx = -3.0e38f;
#pragma unroll
                    for (int bi = 0; bi < 4; ++bi) {
                        const bool valid = (bi == 3) || (bi < nsel);
#pragma unroll
                        for (int i = 0; i < 4; ++i) { sc[bi][i] = -3.0e38f;
                            if (valid) { const int key = blk[bi] * 256 + lane + 64 * i; const bf16* kp = P1 + (size_t)key * LD1 + C_MK + h * 128; float dsum = 0.f;
                                for (int d = 0; d < 128; d += 8) { const u32x4 kv = *(const u32x4*)(kp + d); const f32x4 q0 = *(const LAS f32x4*)(qs + d), q1 = *(const LAS f32x4*)(qs + d + 4);
                                    dsum += (q0.x * bflo(kv.x) + q0.y * bfhi(kv.x)) + (q0.z * bflo(kv.y) + q0.w * bfhi(kv.y)) + (q1.x * bflo(kv.z) + q1.y * bfhi(kv.z)) + (q1.z * bflo(kv.w) + q1.w * bfhi(kv.w)); }
                                if (bi < 3 || key <= t) sc[bi][i] = dsum * 0.08838834764831845f; }
                            mx = fmaxf(mx, sc[bi][i]); } }
                    mx = wave_max(mx); float sum = 0.f;
#pragma unroll
                    for (int bi = 0; bi < 4; ++bi)
#pragma unroll
                        for (int i = 0; i < 4; ++i) { const float p = (sc[bi][i] > -1.0e38f) ? __expf(sc[bi][i] - mx) : 0.f; sc[bi][i] = p; sum += p; }
                    sum = wave_sum(sum); const float inv = 1.0f / sum;
#pragma unroll
                    for (int bi = 0; bi < 4; ++bi)
#pragma unroll
                        for (int i = 0; i < 4; ++i) ps[bi * 256 + lane + 64 * i] = sc[bi][i] * inv;
                    asm volatile("s_waitcnt lgkmcnt(0)" ::: "memory");
                    float o0 = 0.f, o1 = 0.f;
#pragma unroll
                    for (int bi = 0; bi < 4; ++bi) {
                        const bool valid = (bi == 3) || (bi < nsel);
                        if (valid) { const bf16* vp = P1 + (size_t)(blk[bi] * 256) * LD1 + C_MV + h * 128 + 2 * lane; const int nk = (bi == 3) ? (t - own * 256 + 1) : 256;
#pragma unroll 4
                            for (int k = 0; k < nk; ++k) { const float p = ps[bi * 256 + k]; const unsigned w = *(const unsigned*)(vp + (size_t)k * LD1); o0 += p * bflo(w); o1 += p * bfhi(w); } } }
                    *(unsigned*)(OMOBA + (size_t)t * 1024 + h * 128 + 2 * lane) = pk2(o0, o1);
                }
            }
        }
        SEAM(pb + 2);
        if (PHON(3) && IN(pb + 3)) { PTRS();
            LAS float* sq = (LAS float*)lds;
            LAS float* ss = (LAS float*)(lds + 33792);
            const float* gnorm = (const float*)kin[I_GLA_NORM] + l * 256;
            for (int u = bid; u < 4 * 128; u += G) {
                const int h = u >> 7, ch = u & 127, t0 = ch * 64; const int c = tid >> 3, eg = tid & 7;
                __syncthreads();
                for (int i = tid; i < 64 * 128; i += 512) sq[(i >> 7) * 132 + (i & 127)] = bf2f(QDEC[(size_t)(t0 + (i >> 7)) * 512 + h * 128 + (i & 127)]);
                float o[2][16];
#pragma unroll
                for (int hf = 0; hf < 2; ++hf) {
                    __syncthreads();
                    for (int i = tid; i < 128 * 32; i += 512) { const int d = i >> 5, e4 = (i & 31) * 4; *(LAS f32x4*)(ss + d * 128 + e4) = *(const f32x4*)(GKV + ((size_t)u * 128 + d) * 256 + hf * 128 + e4); }
                    __syncthreads();
                    const float* oi = OINTRA + (size_t)(t0 + c) * 1024 + h * 256 + hf * 128 + eg * 16;
#pragma unroll
                    for (int i = 0; i < 16; i += 4) { const f32x4 v = *(const f32x4*)(oi + i); o[hf][i] = v.x; o[hf][i + 1] = v.y; o[hf][i + 2] = v.z; o[hf][i + 3] = v.w; }
                    for (int d = 0; d < 128; ++d) { const float qv = sq[c * 132 + d];
#pragma unroll
                        for (int i = 0; i < 16; i += 4) { const f32x4 sv4 = *(const LAS f32x4*)(ss + d * 128 + eg * 16 + i); o[hf][i] += qv * sv4.x; o[hf][i + 1] += qv * sv4.y; o[hf][i + 2] += qv * sv4.z; o[hf][i + 3] += qv * sv4.w; } }
                }
                float sqs = 0.f;
#pragma unroll
                for (int hf = 0; hf < 2; ++hf)
#pragma unroll
                    for (int i = 0; i < 16; ++i) sqs += o[hf][i] * o[hf][i];
                sqs += __shfl_xor(sqs, 1); sqs += __shfl_xor(sqs, 2); sqs += __shfl_xor(sqs, 4);
                const float rs = 1.0f / sqrtf(sqs * (1.0f / 256.0f) + EPS);
#pragma unroll
                for (int hf = 0; hf < 2; ++hf) { const int e0 = hf * 128 + eg * 16; const bf16* grp = P1 + (size_t)(t0 + c) * LD1 + C_GR + h * 256 + e0; unsigned ow[8];
#pragma unroll
                    for (int i = 0; i < 16; i += 2) { const unsigned gw2 = *(const unsigned*)(grp + i); const float g0 = bflo(gw2), g1 = bfhi(gw2);
                        const float y0 = o[hf][i] * rs * gnorm[e0 + i] * (g0 * sigmoidf_(g0)), y1 = o[hf][i + 1] * rs * gnorm[e0 + i + 1] * (g1 * sigmoidf_(g1)); ow[i >> 1] = pk2(y0, y1); }
                    bf16* op = OGLA + (size_t)(t0 + c) * 1024 + h * 256 + e0;
                    *(u32x4*)op = (u32x4){ow[0], ow[1], ow[2], ow[3]}; *(u32x4*)(op + 8) = (u32x4){ow[4], ow[5], ow[6], ow[7]}; }
            }
        }
        SEAM(pb + 3);
        if (PHON(4) && IN(pb + 4)) { PTRS();
            for (int u = bid; u < 64 * 16; u += G) {
                const int rt = u >> 4, ct = u & 15;
                f32x4 macc[2][4]; sg_zero(macc);
#pragma unroll 1
                for (int n = 0; n < 3; ++n) {
                    const bf16* An = (n == 0) ? OMOBA : (n == 1) ? OGLA : OPOOL;
                    f32x4 acc[2][4]; sg_zero(acc);
                    sg_tile(lds, An + (size_t)rt * 128 * 1024, 1024, (const bf16*)(wl + WL_WBRT) + (size_t)n * DM * 1024 + (size_t)ct * 128 * 1024, 1024, 1024, acc, tid);
                    const int lw = tid >> 6;
#pragma unroll
                    for (int mt = 0; mt < 2; ++mt)
#pragma unroll
                        for (int nt = 0; nt < 4; ++nt) { const int row = rt * 128 + (lw >> 1) * 32 + mt * 16 + (lane & 15), col = ct * 128 + (lw & 1) * 64 + nt * 16 + (lane >> 4) * 4;
                            const u32x2 gg = *(const u32x2*)(P1 + (size_t)row * LD1 + C_GATE + n * DM + col);
                            macc[mt][nt].x += bflo(gg.x) * acc[mt][nt].x; macc[mt][nt].y += bfhi(gg.x) * acc[mt][nt].y; macc[mt][nt].z += bflo(gg.y) * acc[mt][nt].z; macc[mt][nt].w += bfhi(gg.y) * acc[mt][nt].w; }
                }
                SG_FOREACH(macc, r, c, v, { const int row = rt * 128 + r, col = ct * 128 + c; u32x2 o; o.x = pk2(v.x, v.y); o.y = pk2(v.z, v.w); *(u32x2*)(MERGED + (size_t)row * DM + col) = o; });
            }
        }
        SEAM(pb + 4);
        if (PHON(5) && IN(pb + 5)) { PTRS();
            const float* xin = (l == 0) ? (const float*)kin[I_X] : XF;
            for (int u = bid; u < 64 * 16; u += G) {
                const int rt = u >> 4, ct = u & 15;
                f32x4 acc[2][4]; sg_zero(acc);
                sg_tile(lds, MERGED + (size_t)rt * 128 * DM, DM, (const bf16*)(wl + WL_WMIXT) + (size_t)ct * 128 * DM, DM, DM, acc, tid);
                SG_FOREACH(acc, r, c, v, { const size_t o = (size_t)(rt * 128 + r) * DM + ct * 128 + c; *(f32x4*)(XF + o) = *(const f32x4*)(xin + o) + v; });
            }
        }
        SEAM(pb + 5);
        if (PHON(6) && IN(pb + 6)) { PTRS(); for (int t = gw; t < NT; t += ngw) row_prep(XF + (size_t)t * DM, XB + (size_t)t * DM, RSTD + t, lane); }
        SEAM(pb + 6);
        if (PHON(7) && IN(pb + 7)) { PTRS();
            for (int u = bid; u < 64 * 4; u += G) {
                const int rt = u >> 2, ct = u & 3;
                f32x4 acc[2][4]; sg_zero(acc);
                sg_tile(lds, XB + (size_t)rt * 128 * DM, DM, (const bf16*)(wl + WL_WXQT) + (size_t)ct * 128 * DM, DM, DM, acc, tid);
                SG_FOREACH(acc, r, c, v, { const int row = rt * 128 + r, col = ct * 128 + c; const float s = RSTD[row];
                    u32x2 o; o.x = pk2(v.x * s, v.y * s); o.y = pk2(v.z * s, v.w * s); *(u32x2*)(XQ + (size_t)row * 512 + col) = o; });
            }
        }
        SEAM(pb + 7);
        if (PHON(8) && IN(pb + 8)) { PTRS();
            LAS float* qs = (LAS float*)(lds + wave * 2048);
            LAS float* ps = (LAS float*)(lds + wave * 2048 + 512);
            const bf16* KVM = (const bf16*)(ws + WS_KVM) + (size_t)l * MEMLEN * 1024;
            for (int it = gw; it < NT * 4; it += ngw) {
                const int t = it >> 2, h = it & 3;
                { const unsigned w = *(const unsigned*)(XQ + (size_t)t * 512 + h * 128 + 2 * lane); qs[2 * lane] = bflo(w); qs[2 * lane + 1] = bfhi(w); }
                asm volatile("s_waitcnt lgkmcnt(0)" ::: "memory");
                float sc[4]; float mx = -3.0e38f;
#pragma unroll
                for (int i = 0; i < 4; ++i) { const bf16* kp = KVM + (size_t)(lane + 64 * i) * 1024 + h * 128; float dsum = 0.f;
                    for (int d = 0; d < 128; d += 8) { const u32x4 kv = *(const u32x4*)(kp + d); const f32x4 q0 = *(const LAS f32x4*)(qs + d), q1 = *(const LAS f32x4*)(qs + d + 4);
                        dsum += (q0.x * bflo(kv.x) + q0.y * bfhi(kv.x)) + (q0.z * bflo(kv.y) + q0.w * bfhi(kv.y)) + (q1.x * bflo(kv.z) + q1.y * bfhi(kv.z)) + (q1.z * bflo(kv.w) + q1.w * bfhi(kv.w)); }
                    sc[i] = dsum * 0.08838834764831845f; mx = fmaxf(mx, sc[i]); }
                mx = wave_max(mx); float sum = 0.f;
#pragma unroll
                for (int i = 0; i < 4; ++i) { sc[i] = __expf(sc[i] - mx); sum += sc[i]; }
                sum = wave_sum(sum); const float inv = 1.0f / sum;
#pragma unroll
                for (int i = 0; i < 4; ++i) ps[lane + 64 * i] = sc[i] * inv;
                asm volatile("s_waitcnt lgkmcnt(0)" ::: "memory");
                float o0 = 0.f, o1 = 0.f; const bf16* vp = KVM + 512 + h * 128 + 2 * lane;
#pragma unroll 4
                for (int k = 0; k < 256; ++k) { const float p = ps[k]; const unsigned w = *(const unsigned*)(vp + (size_t)k * 1024); o0 += p * bflo(w); o1 += p * bfhi(w); }
                *(unsigned*)(XO + (size_t)t * 512 + h * 128 + 2 * lane) = pk2(o0, o1);
            }
        }
        SEAM(pb + 8);
        if (PHON(9) && IN(pb + 9)) { PTRS();
            for (int u = bid; u < 64 * 16; u += G) {
                const int rt = u >> 4, ct = u & 15;
                f32x4 acc[2][4]; sg_zero(acc);
                sg_tile(lds, XO + (size_t)rt * 128 * 512, 512, (const bf16*)(wl + WL_WXOT) + (size_t)ct * 128 * 512, 512, 512, acc, tid);
                SG_FOREACH(acc, r, c, v, { const size_t o = (size_t)(rt * 128 + r) * DM + ct * 128 + c; *(f32x4*)(XF + o) = *(const f32x4*)(XF + o) + v; });
            }
        }
        SEAM(pb + 9);
        if (PHON(10) && IN(pb + 10)) { PTRS(); for (int t = gw; t < NT; t += ngw) row_prep(XF + (size_t)t * DM, XB + (size_t)t * DM, RSTD + t, lane); }
        SEAM(pb + 10);
        if (PHON(11) && IN(pb + 11)) { PTRS();
            const float* brg = (const float*)kin[I_B_RG] + l * 8; const float* bre = (const float*)kin[I_B_RE] + l * 64;
            for (int u = bid; u < 64; u += G) {
                f32x4 acc[2][4]; sg_zero(acc);
                sg_tile(lds, XB + (size_t)u * 128 * DM, DM, (const bf16*)(wl + WL_WRT), DM, DM, acc, tid);
                SG_FOREACH(acc, r, c, v, { const int row = u * 128 + r; const float s = RSTD[row]; f32x4 o;
                    o.x = v.x * s + rbias(brg, bre, c); o.y = v.y * s + rbias(brg, bre, c + 1); o.z = v.z * s + rbias(brg, bre, c + 2); o.w = v.w * s + rbias(brg, bre, c + 3);
                    *(f32x4*)(LOGITS + (size_t)row * 128 + c) = o; });
            }
        }
        SEAM(pb + 11);
        if (PHON(12) && IN(pb + 12)) { PTRS();
            for (int t = gt; t < NT; t += ngt) {
                const float* lg = LOGITS + (size_t)t * 128; float gl[8]; float gmax = -3.0e38f; int gi = 0;
#pragma unroll
                for (int j = 0; j < 8; ++j) { gl[j] = lg[j]; if (gl[j] > gmax) { gmax = gl[j]; gi = j; } }
                float gs = 0.f;
#pragma unroll
                for (int j = 0; j < 8; ++j) gs += __expf(gl[j] - gmax);
                const float gwt = 1.0f / gs;
                float el[8]; float m1 = -3.0e38f; int i1 = 0;
#pragma unroll
                for (int j = 0; j < 8; ++j) { el[j] = lg[8 + gi * 8 + j]; if (el[j] > m1) { m1 = el[j]; i1 = j; } }
                float m2 = -3.0e38f; int i2 = 0;
#pragma unroll
                for (int j = 0; j < 8; ++j) if (j != i1 && el[j] > m2) { m2 = el[j]; i2 = j; }
                const float p2 = __expf(m2 - m1);
                const float w1 = gwt / (1.0f + p2), w2 = gwt * p2 / (1.0f + p2);
                const int e1 = gi * 8 + i1, e2 = gi * 8 + i2;
                ROUTE[RT_EXP + 2 * t] = e1; ROUTE[RT_EXP + 2 * t + 1] = e2;
                ((float*)ROUTE)[RT_WGT + 2 * t] = w1; ((float*)ROUTE)[RT_WGT + 2 * t + 1] = w2;
            }
        }
        SEAM(pb + 12);
        LAS int* mstart = (LAS int*)(lds + MISC_OFF - 1024);
        LAS int* mtile = (LAS int*)(lds + MISC_OFF - 512);
        LAS int* mcnt = (LAS int*)(lds + MISC_OFF - 1536);
#define MOE_TABLES() do { __syncthreads(); if (tid == 0) { const int* cnt_ = ROUTE + RT_CNT + l * 64; int s_ = 0, tt_ = 0; for (int e_ = 0; e_ < NEXP; ++e_) { const int c_ = __hip_atomic_load(cnt_ + e_, __ATOMIC_RELAXED, __HIP_MEMORY_SCOPE_AGENT); \
            const int nt_ = (c_ + TMOE - 1) / TMOE; mstart[e_] = s_; mtile[e_] = tt_; mcnt[e_] = c_; s_ += nt_ * TMOE; tt_ += nt_; } mstart[NEXP] = s_; mtile[NEXP] = tt_; } __syncthreads(); } while (0)
        if (PHON(13) && IN(pb + 13)) { PTRS();
            LAS int* wc = (LAS int*)lds;
            for (int e = bid; e < NEXP; e += G) {
                int v[32]; int c = 0;
#pragma unroll
                for (int j = 0; j < 32; ++j) { v[j] = ROUTE[RT_EXP + wave * 2048 + j * 64 + lane]; c += __popcll(__ballot(v[j] == e)); }
                __syncthreads(); if (lane == 0) wc[wave] = c; __syncthreads();
                int base = 0, tot = 0;
#pragma unroll
                for (int w = 0; w < 8; ++w) { const int x = wc[w]; tot += x; if (w < wave) base += x; }
#pragma unroll
                for (int j = 0; j < 32; ++j) { const unsigned long long m = __ballot(v[j] == e);
                    if (v[j] == e) { const int rk = base + __popcll(m & ((1ull << lane) - 1ull)); const int idx = wave * 2048 + j * 64 + lane; ROUTE[RT_RANK + idx] = rk; TOKOF[e * NT + rk] = idx >> 1; }
                    base += __popcll(m); }
                if (tid == 0) ROUTE[RT_CNT + l * 64 + e] = tot;
            }
        }
        SEAM(pb + 13);
        if (PHON(14) && IN(pb + 14)) { PTRS();
            MOE_TABLES();
            const int ntile = mtile[NEXP];
            for (int u = bid; u < ntile * 8; u += G) {
                const int rtg = u >> 3, ct = u & 7; int e = 0;
                for (int j = 1; j < NEXP; ++j) if (mtile[j] <= rtg) e = j;
                const int row0 = mstart[e] + (rtg - mtile[e]) * TMOE;
                f32x4 acc[2][4]; sg_zero(acc);
                const int rk0 = (rtg - mtile[e]) * TMOE, ce = mcnt[e];
                { const int rk = rk0 + (tid >> 2); const int tok = rk < ce ? TOKOF[e * NT + rk] : 0;
                  sg_tile_rows(lds, XB + (size_t)tok * DM, (const bf16*)(wl + WL_W13T) + (size_t)e * 1024 * DM + (size_t)(ct * 128 + (tid >> 2)) * DM, DM, acc, tid); }
                SG_FOREACH(acc, r, c, v, { const int row = row0 + r, col = ct * 128 + c; const int rk = rk0 + r; const float s = RSTD[rk < ce ? TOKOF[e * NT + rk] : 0];
                    const float g0 = v.x * s, u0 = v.y * s, g1 = v.z * s, u1 = v.w * s;
                    *(unsigned*)(ACT + (size_t)row * DFF + (col >> 1)) = pk2(g0 * sigmoidf_(g0) * u0, g1 * sigmoidf_(g1) * u1); });
            }
        }
        SEAM(pb + 14);
        if (PHON(15) && IN(pb + 15)) { PTRS();
            MOE_TABLES();
            const int ntile = mtile[NEXP];
            for (int u = bid; u < ntile * 16; u += G) {
                const int rtg = u >> 4, ct = u & 15; int e = 0;
                for (int j = 1; j < NEXP; ++j) if (mtile[j] <= rtg) e = j;
                const int row0 = mstart[e] + (rtg - mtile[e]) * TMOE;
                f32x4 acc[2][4]; sg_zero(acc);
                sg_tile(lds, ACT + (size_t)row0 * DFF, DFF, (const bf16*)(wl + WL_W2T) + (size_t)e * DM * DFF + (size_t)ct * 128 * DFF, DFF, DFF, acc, tid);
                SG_FOREACH(acc, r, c, v, { u32x2 o; o.x = pk2(v.x, v.y); o.y = pk2(v.z, v.w); *(u32x2*)(YB + (size_t)(row0 + r) * DM + ct * 128 + c) = o; });
            }
        }
        SEAM(pb + 15);
        if (PHON(16) && IN(pb + 16)) { PTRS();
            MOE_TABLES();
            const float* nfin = (const float*)kin[I_NORM_FINAL];
            for (int t = gw; t < NT; t += ngw) {
                const int d0 = mstart[ROUTE[RT_EXP + 2 * t]] + ROUTE[RT_RANK + 2 * t], d1 = mstart[ROUTE[RT_EXP + 2 * t + 1]] + ROUTE[RT_RANK + 2 * t + 1]; const float w0 = ((const float*)ROUTE)[RT_WGT + 2 * t], w1 = ((const float*)ROUTE)[RT_WGT + 2 * t + 1];
                f32x4 v[8]; float ss = 0.f;
#pragma unroll
                for (int j = 0; j < 8; ++j) { v[j] = ((const f32x4*)(XF + (size_t)t * DM))[lane + 64 * j];
                    const u32x2 y0 = ((const u32x2*)(YB + (size_t)d0 * DM))[lane + 64 * j], y1 = ((const u32x2*)(YB + (size_t)d1 * DM))[lane + 64 * j];
                    v[j].x += w0 * bflo(y0.x) + w1 * bflo(y1.x); v[j].y += w0 * bfhi(y0.x) + w1 * bfhi(y1.x); v[j].z += w0 * bflo(y0.y) + w1 * bflo(y1.y); v[j].w += w0 * bfhi(y0.y) + w1 * bfhi(y1.y);
                    ss += (v[j].x * v[j].x + v[j].y * v[j].y) + (v[j].z * v[j].z + v[j].w * v[j].w); }
                ss = wave_sum(ss); const float rs = 1.0f / sqrtf(ss * (1.0f / DM) + EPS);
                if (l == NLAYER - 1) {
#pragma unroll
                    for (int j = 0; j < 8; ++j) { const f32x4 g = ((const f32x4*)nfin)[lane + 64 * j]; ((f32x4*)((float*)kin[28] + (size_t)t * DM))[lane + 64 * j] = (f32x4){v[j].x * rs * g.x, v[j].y * rs * g.y, v[j].z * rs * g.z, v[j].w * rs * g.w}; }
                } else {
#pragma unroll
                    for (int j = 0; j < 8; ++j) { ((f32x4*)(XF + (size_t)t * DM))[lane + 64 * j] = v[j]; u32x2 o; o.x = pk2(v[j].x, v[j].y); o.y = pk2(v[j].z, v[j].w); ((u32x2*)(XB + (size_t)t * DM))[lane + 64 * j] = o; }
                    if (lane == 0) RSTD[t] = rs;
                }
            }
        }
        SEAM(pb + 16);
    }
#if DBG_STOP >= 0
    if (IN(NPH)) { PTRS();
        const unsigned* w = (const unsigned*)(wsl + 2 * MiB); const size_t nw = (WS_END - 2 * MiB) / 4; float* out = (float*)kin[28];
        for (int i = gt; i < NT * DM; i += ngt) { unsigned h = 0u; for (size_t j = (size_t)i; j < nw; j += (size_t)NT * DM) { const size_t b = 2 * MiB + 4 * j; const bool skip = false; if (!skip) h = h * 0x9E3779B1u + w[j]; } out[i] = (float)(h & 0xffffu); }
    }
#endif
#undef IN
#undef SEAM
}
}

extern "C" void kernel_launch(void* const* d_in, const int* in_sizes, int n_in, void* d_out, int out_size, void* d_ws, size_t ws_size, hipStream_t stream) {
    static int grid = 0;
    if (grid == 0) {
        if (n_in != 28 || out_size != NT * DM || ws_size < WS_END) { fprintf(stderr, "kernel_launch: unexpected problem (n_in %d out %d ws %zu need %zu)\n", n_in, out_size, ws_size, (size_t)WS_END); grid = -1; return; }
        int dev = 0, cus = 0, per_cu = 0;
        if (hipGetDevice(&dev) != hipSuccess || hipDeviceGetAttribute(&cus, hipDeviceAttributeMultiprocessorCount, dev) != hipSuccess) { grid = -1; return; }
        if (hipFuncSetAttribute((const void*)mk_fwd, hipFuncAttributeMaxDynamicSharedMemorySize, LDS_BYTES) != hipSuccess) { fprintf(stderr, "kernel_launch: hipFuncSetAttribute failed\n"); grid = -1; return; }
        if (hipOccupancyMaxActiveBlocksPerMultiprocessor(&per_cu, (const void*)mk_fwd, 512, LDS_BYTES) != hipSuccess || per_cu < 1) fprintf(stderr, "kernel_launch: occupancy query reports %d\n", per_cu);
        (void)hipGetLastError();
        grid = cus;
    }
    if (grid < 0) return;
    (void)hipMemsetAsync((char*)d_ws + WS_CTL, 0, CTL_BYTES, stream);
    Args a{};
    for (int i = 0; i < 28; ++i) a.in[i] = d_in[i];
    a.out = (float*)d_out; a.ws = (unsigned char*)d_ws;
#if MK_ONE_LAUNCH
    a.ph_lo = 0; a.ph_hi = NPH;
    hipLaunchKernelGGL(mk_fwd, dim3(grid), dim3(512), LDS_BYTES, stream, a);
#else
#if DBG_STOP >= 0
    for (int p = 0; p <= DBG_STOP; ++p) { a.ph_lo = p; a.ph_hi = p + 1; hipLaunchKernelGGL(mk_fwd, dim3(grid), dim3(512), LDS_BYTES, stream, a); }
    a.ph_lo = NPH; a.ph_hi = NPH + 1; hipLaunchKernelGGL(mk_fwd, dim3(grid), dim3(512), LDS_BYTES, stream, a);
#else
    for (int p = 0; p < NPH; ++p) { a.ph_lo = p; a.ph_hi = p + 1; hipLaunchKernelGGL(mk_fwd, dim3(grid), dim3(512), LDS_BYTES, stream, a); }
#endif
#endif
}
```

```cpp
#include <hip/hip_runtime.h>
#include <cstdio>
#include <cstdint>

#ifndef DBG_STOP
#define DBG_STOP -1
#endif
#ifndef MK_ONE_LAUNCH
#define MK_ONE_LAUNCH 1
#endif

namespace {
#define LAS __attribute__((address_space(3)))
typedef unsigned short bf16;
typedef short bf16x8 __attribute__((ext_vector_type(8)));
typedef float f32x4 __attribute__((ext_vector_type(4)));
typedef unsigned u32x4 __attribute__((ext_vector_type(4)));
typedef unsigned u32x2 __attribute__((ext_vector_type(2)));
#define GAS __attribute__((address_space(1)))
typedef GAS float g_f32; typedef GAS f32x4 g_f32x4; typedef GAS u32x2 g_u32x2; typedef GAS u32x4 g_u32x4; typedef GAS unsigned g_u32; typedef GAS int g_i32;

constexpr int NT = 8192, DM = 2048, NLAYER = 2, MEMLEN = 256;
constexpr int INW = 7184, GATEW = 6144;
constexpr int C_MQ = 0, C_MK = 1024, C_MV = 2048, C_GQ = 3072, C_GK = 3584, C_GV = 4096, C_GR = 5120, C_PU = 6144, C_GLOW = 7168, C_GATE = 7424;
constexpr int LD1 = C_GATE + GATEW;
constexpr int NEXP = 64, DFF = 512, TMOE = 256, PMAX = 16384 + NEXP * TMOE;
constexpr float EPS = 1e-6f;

constexpr size_t MiB = 1u << 20;
constexpr size_t WS_CTL = 0, CTL_BYTES = 1 * MiB;
constexpr size_t WS_ROPE = 2 * MiB;
constexpr size_t WS_RSTD = 6 * MiB;
constexpr size_t WS_RSTDM = WS_RSTD + 64 * 1024;
constexpr size_t WS_KMEAN = 7 * MiB;
constexpr size_t WS_KVM = 8 * MiB;
constexpr size_t WS_MB = 9 * MiB;
constexpr size_t WS_ROUTE = 10 * MiB;
constexpr size_t WS_GDEC = 11 * MiB;
constexpr size_t WS_LOGITS = 12 * MiB;
constexpr size_t WS_TOKOF = 16 * MiB;
constexpr size_t WS_SEL = 18 * MiB;
constexpr size_t WS_ML = 19 * MiB;
constexpr size_t WS_WL = 32 * MiB;
constexpr size_t WL_W1T = 0;
constexpr size_t WL_WBRT = 56 * MiB;
constexpr size_t WL_WPOOLT = 68 * MiB;
constexpr size_t WL_WMIXT = 69 * MiB;
constexpr size_t WL_WXQT = 77 * MiB;
constexpr size_t WL_WXKVT = 79 * MiB;
constexpr size_t WL_WXOT = 83 * MiB;
constexpr size_t WL_WRT = 85 * MiB;
constexpr size_t WL_W13T = 86 * MiB;
constexpr size_t WL_W2T = 342 * MiB;
constexpr size_t WL_SIZE = 470 * MiB;
constexpr size_t WS_ACTS = WS_WL + 2 * WL_SIZE;
constexpr size_t WS_XF = WS_ACTS;
constexpr size_t WS_XB = WS_XF + 64 * MiB;
constexpr size_t WS_P1 = WS_XB + 32 * MiB;
constexpr size_t WS_OMOBA = WS_P1 + 216 * MiB;
constexpr size_t WS_OGLA = WS_OMOBA + 16 * MiB;
constexpr size_t WS_MIXED = WS_OGLA + 16 * MiB;
constexpr size_t WS_OPOOL = WS_MIXED + 16 * MiB;
constexpr size_t WS_QDEC = WS_OPOOL + 16 * MiB;
constexpr size_t WS_OINTRA = WS_QDEC + 8 * MiB;
constexpr size_t WS_GKV = WS_OINTRA + 32 * MiB;
constexpr size_t WS_MERGED = WS_GKV + 64 * MiB;
constexpr size_t WS_XQ = WS_MERGED + 32 * MiB;
constexpr size_t WS_XO = WS_XQ + 8 * MiB;
constexpr size_t WS_ACT = WS_XO + 8 * MiB;
constexpr size_t WS_Y = WS_ACT + 32 * MiB;
constexpr size_t WS_MF = WS_Y + 128 * MiB;
constexpr size_t WS_OPART = WS_MF + 64 * MiB;
constexpr size_t WS_END = WS_OPART + 64 * MiB;
static_assert((size_t)PMAX * 2048 * 2 <= 128 * MiB && (size_t)LD1 * 2048 * 2 <= 56 * MiB && (size_t)NT * LD1 * 2 <= 216 * MiB, "map");
constexpr int CW_BAR = 4096;
constexpr int CW_CNT = 16384;
constexpr int RT_EXP = 0, RT_RANK = 2 * NT, RT_DEST = 4 * NT, RT_WGT = 6 * NT, RT_CNT = 8 * NT;

constexpr int LDS_BYTES = 147456;
constexpr int MISC_OFF = 147456 - 256;

__device__ __forceinline__ float bflo(unsigned w) { return __uint_as_float(w << 16); }
__device__ __forceinline__ float bfhi(unsigned w) { return __uint_as_float(w & 0xffff0000u); }
__device__ __forceinline__ float bf2f(bf16 b) { return __uint_as_float((unsigned)b << 16); }
__device__ __forceinline__ unsigned pk2(float lo, float hi) { unsigned r; asm("v_cvt_pk_bf16_f32 %0, %1, %2" : "=v"(r) : "v"(lo), "v"(hi)); return r; }
__device__ __forceinline__ float wave_sum(float v) {
#pragma unroll
    for (int o = 1; o < 64; o <<= 1) v += __shfl_xor(v, o);
    return v;
}
__device__ __forceinline__ float wave_max(float v) {
#pragma unroll
    for (int o = 1; o < 64; o <<= 1) v = fmaxf(v, __shfl_xor(v, o));
    return v;
}
__device__ __forceinline__ float sigmoidf_(float x) { return 1.0f / (1.0f + __expf(-x)); }

#define XB_TMO      128
#define XB_XCNT(j)  (256  + 64 * (j))
#define XB_XSUB(j)  (1280 + 64 * (j))
#define XB_XGEN(j)  (2304 + 64 * (j))
#define XB_TOP      3328
#define XB_TOPGEN   3392
#define XCD_BAR_WORDS 3456
#define XB_SPIN_CAP (1u << 18)

__device__ __forceinline__ unsigned xb_ld(unsigned* p)              { return __hip_atomic_load(p, __ATOMIC_RELAXED, __HIP_MEMORY_SCOPE_AGENT); }
__device__ __forceinline__ unsigned xb_add(unsigned* p, unsigned v) { return __hip_atomic_fetch_add(p, v, __ATOMIC_RELAXED, __HIP_MEMORY_SCOPE_AGENT); }
__device__ __forceinline__ unsigned xb_xcc_id() { return (unsigned)__builtin_amdgcn_s_getreg((3 << 11) | 20) & 0xFu; }
#define XB_SPIN(cond, bar) do { unsigned _sp = 0; while (cond) { __builtin_amdgcn_s_sleep(1); \
    if ((++_sp & 255u) == 0u) { if (xb_ld(&(bar)[XB_TMO])) break; if (_sp > XB_SPIN_CAP) { atomicAdd(&(bar)[XB_TMO], 1u); break; } } } } while (0)

struct XcdBarrier { unsigned* bar; unsigned x; volatile LAS unsigned* st; };

__device__ __forceinline__ XcdBarrier xcd_barrier_post(unsigned* bar, volatile LAS unsigned* st) {
    XcdBarrier b; b.bar = bar; b.x = xb_xcc_id(); b.st = st;
    if (threadIdx.x == 0) (void)xb_add(&bar[XB_XCNT(b.x)], 1u);
    return b;
}
__device__ __forceinline__ void xcd_barrier_complete(unsigned* bar, unsigned x, unsigned& nloc, unsigned& nx) {
    const unsigned G = gridDim.x * gridDim.y * gridDim.z;
    unsigned sum, cnt, mine, sp = 0u;
    for (;;) {
        sum = 0u; cnt = 0u; mine = 0u;
#pragma unroll
        for (unsigned j = 0; j < 16; ++j) { const unsigned c = xb_ld(&bar[XB_XCNT(j)]); sum += c; cnt += (c > 0u) ? 1u : 0u; mine = (j == x) ? c : mine; }
        if (sum == G) break;
        __builtin_amdgcn_s_sleep(1);
        if ((++sp & 255u) == 0u) { if (xb_ld(&bar[XB_TMO])) break; if (sp > XB_SPIN_CAP) { atomicAdd(&bar[XB_TMO], 1u); break; } }
    }
    nloc = mine > 0u ? mine : 1u; nx = cnt > 0u ? cnt : 1u;
}
__device__ __forceinline__ void xcd_barrier(const XcdBarrier& b) {
    asm volatile("s_waitcnt vmcnt(0)" ::: "memory");
    __syncthreads();
    if (threadIdx.x == 0) {
        unsigned* bar = b.bar;
        __builtin_amdgcn_s_waitcnt(0);
        unsigned nloc = b.st[0], nx = b.st[1];
        if (nloc == 0u) { xcd_barrier_complete(bar, b.x, nloc, nx); b.st[0] = nloc; b.st[1] = nx; }
        const unsigned old = xb_add(&bar[XB_XSUB(b.x)], 1u);
        const unsigned gen = old / nloc;
        if (old + 1u == (gen + 1u) * nloc) {
            __builtin_amdgcn_fence(__ATOMIC_RELEASE, "agent");
            asm volatile("s_waitcnt vmcnt(0)" ::: "memory");
            const unsigned og = xb_add(&bar[XB_TOP], 1u);
            const unsigned tg = og / nx;
            if (og + 1u == (tg + 1u) * nx) xb_add(&bar[XB_TOPGEN], 1u);
            else XB_SPIN(xb_ld(&bar[XB_TOPGEN]) == tg, bar);
            __builtin_amdgcn_fence(__ATOMIC_ACQUIRE, "agent");
            xb_add(&bar[XB_XGEN(b.x)], 1u);
            asm volatile("s_waitcnt vmcnt(0)" ::: "memory");
        } else {
            XB_SPIN(xb_ld(&bar[XB_XGEN(b.x)]) == gen, bar);
            __builtin_amdgcn_fence(__ATOMIC_ACQUIRE, "agent");
            asm volatile("s_waitcnt vmcnt(0)" ::: "memory");
        }
    }
    __syncthreads();
}

constexpr int SG_LDS = 2 * 128 * 80;
__device__ __forceinline__ void sg_tile_rows(LAS unsigned char* lds, const bf16* __restrict__ arow, const bf16* __restrict__ brow, int K, f32x4 (&acc)[2][4], const int tid) {
    const int lane = tid & 63, wid = tid >> 6, wm = wid >> 1, wn = wid & 1;
    const int lr = tid >> 2, lc = tid & 3, fr = lane & 15, fq = lane >> 4;
    const u32x4* ga = (const u32x4*)arow + lc;
    const u32x4* gb = (const u32x4*)brow + lc;
    u32x4 ra = ga[0], rb = gb[0];
#pragma unroll 1
    for (int k0 = 0; k0 < K; k0 += 32) {
        __syncthreads();
        *(LAS u32x4*)(lds + lr * 80 + lc * 16) = ra;
        *(LAS u32x4*)(lds + 10240 + lr * 80 + lc * 16) = rb;
        __syncthreads();
        if (k0 + 32 < K) { ra = ga[(k0 + 32) >> 3]; rb = gb[(k0 + 32) >> 3]; }
        bf16x8 af[2], bfr[4];
#pragma unroll
        for (int mt = 0; mt < 2; ++mt) af[mt] = *(const LAS bf16x8*)(lds + (wm * 32 + mt * 16 + fr) * 80 + fq * 16);
#pragma unroll
        for (int nt = 0; nt < 4; ++nt) bfr[nt] = *(const LAS bf16x8*)(lds + 10240 + (wn * 64 + nt * 16 + fr) * 80 + fq * 16);
#pragma unroll
        for (int mt = 0; mt < 2; ++mt)
#pragma unroll
            for (int nt = 0; nt < 4; ++nt) acc[mt][nt] = __builtin_amdgcn_mfma_f32_16x16x32_bf16(bfr[nt], af[mt], acc[mt][nt], 0, 0, 0);
    }
}
__device__ __forceinline__ void sg_tile(LAS unsigned char* lds, const bf16* __restrict__ A, int lda, const bf16* __restrict__ Bt, int ldb, int K, f32x4 (&acc)[2][4], const int tid) {
    sg_tile_rows(lds, A + (size_t)(tid >> 2) * lda, Bt + (size_t)(tid >> 2) * ldb, K, acc, tid);
}
__device__ __forceinline__ void sg_zero(f32x4 (&acc)[2][4]) {
#pragma unroll
    for (int mt = 0; mt < 2; ++mt)
#pragma unroll
        for (int nt = 0; nt < 4; ++nt) acc[mt][nt] = (f32x4){0.f, 0.f, 0.f, 0.f};
}
#define SG_FOREACH(acc, ROW, COL, V, ...) do { const int _l = tid & 63, _w = tid >> 6; \
    _Pragma("unroll") for (int _mt = 0; _mt < 2; ++_mt) _Pragma("unroll") for (int _nt = 0; _nt < 4; ++_nt) { \
        const int ROW = (_w >> 1) * 32 + _mt * 16 + (_l & 15), COL = (_w & 1) * 64 + _nt * 16 + (_l >> 4) * 4; const f32x4 V = acc[_mt][_nt]; __VA_ARGS__ } } while (0)


namespace pg8 {
constexpr int BM = 256, BK = 64, HALF = 128, HTB = HALF * BK * 2, STAGE_BYTES = 8 * HTB;
__device__ __forceinline__ int lds_byte(int r, int c) { const int st = (r >> 4) * 2 + (c >> 5), rr = r & 15, cc = c & 31, ob = rr * 64 + cc * 2; return st * 1024 + (ob ^ (((ob >> 9) & 1) << 5)); }
__device__ __forceinline__ void stage_rc(int b, int& R, int& C) { const int st = b / 1024, sb = b % 1024, swz = sb ^ (((sb >> 9) & 1) << 5); R = (st >> 1) * 16 + swz / 64; C = (st & 1) * 32 + (swz % 64) / 2; }
struct Unit { int pm, pn, x, y; };
struct StaticOrder {
    int nM, nN, nwg, G, c;
    __device__ __forceinline__ void init(int nM_, int nN_, int G_, int c_) { nM = nM_; nN = nN_; nwg = nM * nN; G = G_; c = c_; }
    __device__ __forceinline__ bool next(int i, int& pm, int& pn) const {
        const int L = i * G + c; if (L >= nwg) return false;
        int wgid = L; { const int q = nwg / 8, r = nwg % 8, xcd = wgid % 8, off = wgid / 8; wgid = (xcd < r ? xcd * (q + 1) : r * (q + 1) + (xcd - r) * q) + off; }
        const int nig = 8 * nN, gid = wgid / nig, fm = gid * 8, gsz = (nM - fm) < 8 ? (nM - fm) : 8;
        pm = fm + ((wgid % nig) % gsz); pn = (wgid % nig) / gsz; return true;
    }
};
#define PG_FOREACH(acc, ROW, COL, V, ...) do { \
    _Pragma("unroll") for (int _ai = 0; _ai < 2; ++_ai) _Pragma("unroll") for (int _m = 0; _m < 4; ++_m) \
    _Pragma("unroll") for (int _bj = 0; _bj < 2; ++_bj) _Pragma("unroll") for (int _n = 0; _n < 2; ++_n) { \
        const int ROW = _ai * 128 + wr * 64 + _m * 16 + fr, COL = _bj * 128 + wc * 32 + _n * 16 + fq * 4; const f32x4 V = acc[_ai][_bj][_m][_n]; __VA_ARGS__ } } while (0)

template <class Epi, class Sched>
__device__ __forceinline__ void gemm_phase(LAS unsigned char* lds, const Sched& S, const Epi& E, const int K, const int tid) {
    const int wid = __builtin_amdgcn_readfirstlane(tid >> 6), lane = tid & 63, wr = wid >> 2, wc = wid & 3, fr = lane & 15, fq = lane >> 4;
    const int nt = K / BK;
    int R[2], C[2];
#pragma unroll
    for (int i = 0; i < 2; ++i) stage_rc(tid * 16 + i * 8192, R[i], C[i]);
    unsigned voffB[2];
#pragma unroll
    for (int i = 0; i < 2; ++i) voffB[i] = (unsigned)(R[i] * S.ldb + C[i]) * 2u;
    const size_t kstep = (size_t)(BK * 2);
    const size_t hstepB = (size_t)HALF * S.ldb * 2;
    const unsigned ldsw = (unsigned)wid * 1024u;
    const int aoff = lds_byte(wr * 64 + fr, fq * 8), boff = lds_byte(wc * 32 + fr, fq * 8);
#define PG8_SA(b, h) (((b) * 2 + (h)) * HTB)
#define PG8_SB(b, h) ((4 + (b) * 2 + (h)) * HTB)
#define PG8_STAGE(bufoff, gbase, voff) do { _Pragma("unroll") for (int _i = 0; _i < 2; ++_i) \
        __builtin_amdgcn_global_load_lds((const unsigned*)((const char*)(gbase) + (voff)[_i]), (LAS unsigned*)(lds + (bufoff) + ldsw + _i * 8192), 16, 0, 0); } while (0)
#define PG8_LDA(dst, b, h) do { _Pragma("unroll") for (int m = 0; m < 4; ++m) _Pragma("unroll") for (int k = 0; k < 2; ++k) dst[m][k] = *(const LAS bf16x8*)(lds + PG8_SA(b, h) + aoff + m * 2048 + k * 1024); } while (0)
#define PG8_LDB(dst, b, h) do { _Pragma("unroll") for (int n = 0; n < 2; ++n) _Pragma("unroll") for (int k = 0; k < 2; ++k) dst[n][k] = *(const LAS bf16x8*)(lds + PG8_SB(b, h) + boff + n * 2048 + k * 1024); } while (0)
#define PG8_MMA(ai, bj, At, Bt) do { __builtin_amdgcn_s_setprio(1); _Pragma("unroll") for (int m = 0; m < 4; ++m) _Pragma("unroll") for (int n = 0; n < 2; ++n) _Pragma("unroll") for (int k = 0; k < 2; ++k) \
        acc[ai][bj][m][n] = __builtin_amdgcn_mfma_f32_16x16x32_bf16(Bt[n][k], At[m][k], acc[ai][bj][m][n], 0, 0, 0); __builtin_amdgcn_s_setprio(0); } while (0)
#define PG8_WAIT_V(n) asm volatile("s_waitcnt vmcnt(" #n ")" ::: "memory")
#define PG8_WAIT_L(n) asm volatile("s_waitcnt lgkmcnt(" #n ")" ::: "memory")
#define PG8_BAR __builtin_amdgcn_s_barrier()
#define PG8_SCHED __builtin_amdgcn_sched_barrier(0)
    Unit cur, nxt; int ui = 0;
    if (!S.next(0, cur)) return;
    f32x4 acc[2][2][4][2];
#pragma unroll
    for (int a = 0; a < 2; ++a)
#pragma unroll
        for (int b = 0; b < 2; ++b)
#pragma unroll
            for (int m = 0; m < 4; ++m)
#pragma unroll
                for (int n = 0; n < 2; ++n) acc[a][b][m][n] = (f32x4){0.f, 0.f, 0.f, 0.f};
    bf16x8 At[4][2], B0[2][2], B1[2][2];
    unsigned voffA[2][2], nvoffA[2][2];
#pragma unroll
    for (int h = 0; h < 2; ++h)
#pragma unroll
        for (int i = 0; i < 2; ++i) voffA[h][i] = S.avoff(cur, R[i], C[i], h);
#define PG8_UNI(p) ((const char*)(((unsigned long long)(unsigned)__builtin_amdgcn_readfirstlane((int)((unsigned long long)(p) >> 32)) << 32) | (unsigned)__builtin_amdgcn_readfirstlane((int)(unsigned long long)(p))))
    const char* cA = PG8_UNI(S.abase(cur)); const char* cB = PG8_UNI(S.bbase(cur));
    PG8_STAGE(PG8_SB(0, 0), cB, voffB); PG8_STAGE(PG8_SA(0, 0), cA, voffA[0]); PG8_STAGE(PG8_SB(0, 1), cB + hstepB, voffB); PG8_STAGE(PG8_SA(0, 1), cA, voffA[1]);
    if (wr == 1) PG8_BAR;
    PG8_WAIT_V(4); PG8_BAR;
    PG8_STAGE(PG8_SB(1, 0), cB + kstep, voffB); PG8_STAGE(PG8_SA(1, 0), cA + kstep, voffA[0]); PG8_STAGE(PG8_SB(1, 1), cB + hstepB + kstep, voffB);
    PG8_WAIT_V(6); PG8_BAR;
    for (;;) {
        const bool has_next = S.next(ui + 1, nxt);
        const char* nA = has_next ? PG8_UNI(S.abase(nxt)) : cA; const char* nB = has_next ? PG8_UNI(S.bbase(nxt)) : cB;
#pragma unroll
        for (int h = 0; h < 2; ++h)
#pragma unroll
            for (int i = 0; i < 2; ++i) nvoffA[h][i] = has_next ? S.avoff(nxt, R[i], C[i], h) : voffA[h][i];
        for (int t = 0; t < nt; t += 2) {
            const bool last = (t == nt - 2);
            const char* a1 = cA + (size_t)(t + 1) * kstep;
            const char* a2 = last ? nA : cA + (size_t)(t + 2) * kstep; const char* b2 = last ? nB : cB + (size_t)(t + 2) * kstep;
            const char* a3 = a2 + kstep; const char* b3 = b2 + kstep;
            unsigned vo2[2][2];
#pragma unroll
            for (int h = 0; h < 2; ++h)
#pragma unroll
                for (int i = 0; i < 2; ++i) vo2[h][i] = last ? nvoffA[h][i] : voffA[h][i];
            PG8_LDB(B0, 0, 0); PG8_SCHED; PG8_LDA(At, 0, 0); PG8_STAGE(PG8_SA(1, 1), a1, voffA[1]);
            PG8_WAIT_L(8); PG8_BAR; PG8_WAIT_L(0); PG8_MMA(0, 0, At, B0); PG8_BAR; PG8_SCHED;
            PG8_LDB(B1, 0, 1); PG8_STAGE(PG8_SB(0, 0), b2, voffB);
            PG8_BAR; PG8_WAIT_L(0); PG8_MMA(0, 1, At, B1); PG8_BAR;
            PG8_LDA(At, 0, 1); PG8_STAGE(PG8_SA(0, 0), a2, vo2[0]);
            PG8_BAR; PG8_WAIT_L(0); PG8_MMA(1, 0, At, B0); PG8_BAR; PG8_SCHED;
            PG8_STAGE(PG8_SB(0, 1), b2 + hstepB, voffB);
            PG8_WAIT_V(6); PG8_BAR; PG8_MMA(1, 1, At, B1); PG8_BAR;
            PG8_LDB(B0, 1, 0); PG8_SCHED; PG8_LDA(At, 1, 0); PG8_STAGE(PG8_SA(0, 1), a2, vo2[1]);
            PG8_WAIT_L(8); PG8_BAR; PG8_WAIT_L(0); PG8_MMA(0, 0, At, B0); PG8_BAR; PG8_SCHED;
            PG8_LDB(B1, 1, 1); PG8_STAGE(PG8_SB(1, 0), b3, voffB);
            PG8_BAR; PG8_WAIT_L(0); PG8_MMA(0, 1, At, B1); PG8_BAR;
            PG8_LDA(At, 1, 1); PG8_STAGE(PG8_SA(1, 0), a3, vo2[0]);
            PG8_BAR; PG8_WAIT_L(0); PG8_MMA(1, 0, At, B0); PG8_BAR; PG8_SCHED;
            PG8_STAGE(PG8_SB(1, 1), b3 + hstepB, voffB);
            PG8_WAIT_V(6); PG8_BAR; PG8_MMA(1, 1, At, B1); PG8_BAR;
        }
        E(acc, cur, wr, wc, fr, fq);
        if (!has_next) break;
#pragma unroll
        for (int a = 0; a < 2; ++a)
#pragma unroll
            for (int b = 0; b < 2; ++b)
#pragma unroll
                for (int m = 0; m < 4; ++m)
#pragma unroll
                    for (int n = 0; n < 2; ++n) acc[a][b][m][n] = (f32x4){0.f, 0.f, 0.f, 0.f};
        cur = nxt; cA = nA; cB = nB; ++ui;
#pragma unroll
        for (int h = 0; h < 2; ++h)
#pragma unroll
            for (int i = 0; i < 2; ++i) voffA[h][i] = nvoffA[h][i];
    }
    PG8_WAIT_V(0);
    if (wr == 0) PG8_BAR;
    PG8_BAR;
#undef PG8_UNI
#undef PG8_SA
#undef PG8_SB
#undef PG8_STAGE
#undef PG8_LDA
#undef PG8_LDB
#undef PG8_MMA
#undef PG8_WAIT_V
#undef PG8_WAIT_L
#undef PG8_BAR
#undef PG8_SCHED
}
struct PlainSched {
    const bf16* A; const bf16* Bt; int lda, ldb; StaticOrder ord;
    __device__ __forceinline__ bool next(int i, Unit& u) const { u.x = 0; u.y = 0; return ord.next(i, u.pm, u.pn); }
    __device__ __forceinline__ const char* abase(const Unit& u) const { return (const char*)(A + (size_t)u.pm * 256 * lda); }
    __device__ __forceinline__ const char* bbase(const Unit& u) const { return (const char*)(Bt + (size_t)u.pn * 256 * ldb); }
    __device__ __forceinline__ unsigned avoff(const Unit&, int R, int C, int h) const { return (unsigned)((h * 128 + R) * lda + C) * 2u; }
};
}

struct MapOff { int off; __device__ __forceinline__ int operator()(int c) const { return off + c; } };
struct MapRope { __device__ __forceinline__ int operator()(int c) const { if (c >= 2048) return c; const int d = c & 127; const int j = (d < 64) ? 2 * d : 2 * (d - 64) + 1; return (c & ~127) + j; } };
struct MapIl { int par; __device__ __forceinline__ int operator()(int c) const { return 2 * c + par; } };
template <class Map>
__device__ __forceinline__ void transpose_mat(const float* __restrict__ W, int ldw, int K, int ncols, bf16* WT, int ldt, const float* __restrict__ kscale, Map map, LAS float* scr, int gw, int ngw, int lane) {
    const int nblk = ncols / 32, items = (K / 64) * nblk;
    for (int it = gw; it < items; it += ngw) {
        const int kb = it / nblk, nb = it % nblk, k0 = 64 * kb, n0 = 32 * nb;
#pragma unroll 8
        for (int i = 0; i < 32; ++i) { const int kk = 2 * i + (lane >> 5); float v = W[(size_t)(k0 + kk) * ldw + n0 + (lane & 31)]; if (kscale) v *= kscale[k0 + kk]; scr[kk * 33 + (lane & 31)] = v; }
        asm volatile("s_waitcnt lgkmcnt(0)" ::: "memory");
        const int c = lane & 7;
#pragma unroll
        for (int j = 0; j < 4; ++j) { const int n = (lane >> 3) + 8 * j; const LAS float* s = scr + (8 * c) * 33 + n;
            u32x4 o; o.x = pk2(s[0 * 33], s[1 * 33]); o.y = pk2(s[2 * 33], s[3 * 33]); o.z = pk2(s[4 * 33], s[5 * 33]); o.w = pk2(s[6 * 33], s[7 * 33]);
            *(u32x4*)(WT + (size_t)map(n0 + n) * ldt + k0 + 8 * c) = o; }
        asm volatile("s_waitcnt lgkmcnt(0)" ::: "memory");
    }
}
__device__ __forceinline__ void transpose_small(const float* __restrict__ W, int ldw, int K, int ncols, bf16* WT, int ldt, int row_off, const float* __restrict__ kscale, int gt, int ngt) {
    for (int i = gt; i < K * ncols; i += ngt) { const int n = i / K, k = i % K; float v = W[(size_t)k * ldw + n]; if (kscale) v *= kscale[k]; WT[(size_t)(row_off + n) * ldt + k] = (bf16)(pk2(v, 0.f) & 0xffffu); }
}


typedef int i32x4 __attribute__((ext_vector_type(4)));
#define MFMA_PIN(accv, af, bf_) do { accv = __builtin_amdgcn_mfma_f32_16x16x32_bf16(af, bf_, accv, 0, 0, 0); asm volatile("" : "+v"(accv) : "v"(af), "v"(bf_)); } while (0)
__device__ __forceinline__ float opaque_zero() { float z; asm volatile("v_mov_b32 %0, 0" : "=v"(z)); return z; }

__device__ __forceinline__ void moba_gate(LAS unsigned char* lds, const bf16* P1, const float* KMEAN, int* SEL, const int bid, const int G, const int tid) {
    LAS float* km = (LAS float*)lds;
    LAS float* sc = (LAS float*)(lds + 16384);
    for (int u = bid; u < 256; u += G) {
        const int h = u >> 5, blk = u & 31;
        __syncthreads();
        for (int i = tid; i < 32 * 128 / 4; i += 512) ((LAS f32x4*)km)[i] = ((const g_f32x4*)(KMEAN + h * 32 * 128))[i];
        __syncthreads();
        const int tl = tid & 255, jh = tid >> 8, t = blk * 256 + tl;
        float a[16];
#pragma unroll
        for (int jj = 0; jj < 16; ++jj) a[jj] = 0.f;
        const bf16* qp = P1 + (size_t)t * LD1 + C_MQ + h * 128;
        if (jh * 16 < blk) {
            for (int d = 0; d < 128; d += 8) {
                const u32x4 qv = *(const g_u32x4*)(qp + d);
                const float q0 = bflo(qv.x), q1 = bfhi(qv.x), q2 = bflo(qv.y), q3 = bfhi(qv.y), q4 = bflo(qv.z), q5 = bfhi(qv.z), q6 = bflo(qv.w), q7 = bfhi(qv.w);
#pragma unroll
                for (int jj = 0; jj < 16; ++jj) { const LAS float* kp = km + (jh * 16 + jj) * 128 + d; const f32x4 k0 = *(const LAS f32x4*)kp, k1 = *(const LAS f32x4*)(kp + 4);
                    a[jj] += (q0 * k0.x + q1 * k0.y) + (q2 * k0.z + q3 * k0.w) + (q4 * k1.x + q5 * k1.y) + (q6 * k1.z + q7 * k1.w); }
            }
        }
#pragma unroll
        for (int jj = 0; jj < 16; ++jj) sc[tl * 33 + jh * 16 + jj] = a[jj];
        __syncthreads();
        if (jh == 0) {
            float v0 = -3.0e38f, v1 = -3.0e38f, v2 = -3.0e38f; int i0 = -1, i1 = -1, i2 = -1;
            for (int j = 0; j < blk; ++j) { const float x = sc[tl * 33 + j];
                if (x > v0) { v2 = v1; i2 = i1; v1 = v0; i1 = i0; v0 = x; i0 = j; } else if (x > v1) { v2 = v1; i2 = i1; v1 = x; i1 = j; } else if (x > v2) { v2 = x; i2 = j; } }
            *(GAS i32x4*)(SEL + ((size_t)t * 8 + h) * 4) = (i32x4){i0, i1, i2, 0};
        }
    }
}

__device__ __forceinline__ void moba_attn(LAS unsigned char* lds, const bf16* P1, const int* SEL, bf16* OPART, float* ML, const int bid, const int G, const int tid) {
    const int lane = tid & 63, wave = __builtin_amdgcn_readfirstlane(tid >> 6), fr = lane & 15, g = lane >> 4;
    LAS bf16* Ks = (LAS bf16*)lds;
    LAS bf16* Vt = (LAS bf16*)(lds + 69632);
    LAS unsigned short* list = (LAS unsigned short*)(lds + 137216);
    LAS int* wcnt = (LAS int*)(lds + 141312);
    for (int uu = bid; uu < 1024; uu += G) {
        const int s = uu >> 8, w = uu & 255, jq = w >> 3, h = w & 7;
        const int j = (s == 0) ? jq : (s == 1) ? 31 - jq : (s == 2) ? ((jq + 16) & 31) : ((15 - jq) & 31);
        __syncthreads();
#pragma unroll 4
        for (int i = tid; i < 256 * 16; i += 512) { const int key = i >> 4, c8 = (i & 15) * 8; const bf16* rp = P1 + (size_t)(j * 256 + key) * LD1 + h * 128 + c8;
            const u32x4 kv = *(const g_u32x4*)(rp + C_MK); const u32x4 vv = *(const g_u32x4*)(rp + C_MV);
            *(LAS u32x4*)(Ks + key * 136 + c8) = kv;
            LAS bf16* vp = Vt + c8 * 264 + key;
            vp[0 * 264] = (bf16)vv.x; vp[1 * 264] = (bf16)(vv.x >> 16); vp[2 * 264] = (bf16)vv.y; vp[3 * 264] = (bf16)(vv.y >> 16);
            vp[4 * 264] = (bf16)vv.z; vp[5 * 264] = (bf16)(vv.z >> 16); vp[6 * 264] = (bf16)vv.w; vp[7 * 264] = (bf16)(vv.w >> 16); }
        const int t_first = (j + 1) * 256, per_wave = 32 * (31 - j), wbase = t_first + wave * per_wave;
        int ms[16]; int c = 0;
#pragma unroll
        for (int it = 0; it < 16; ++it) { const int o = it * 64 + lane; int m = -1;
            if (o < per_wave) { const i32x4 sv = *(const GAS i32x4*)(SEL + ((size_t)(wbase + o) * 8 + h) * 4); m = (sv.x == j) ? 0 : (sv.y == j) ? 1 : (sv.z == j) ? 2 : -1; }
            ms[it] = m; c += __popcll(__ballot(m >= 0)); }
        if (lane == 0) wcnt[wave] = c;
        __syncthreads();
        int base = 0, nsel = 0;
#pragma unroll
        for (int ww = 0; ww < 8; ++ww) { const int x = wcnt[ww]; nsel += x; if (ww < wave) base += x; }
        const int n = 256 + nsel, lo = (s * n) >> 2, hi = ((s + 1) * n) >> 2, L = hi - lo;
        if (tid < 256) { if (tid >= lo && tid < hi) list[tid - lo] = (unsigned short)((j * 256 + tid) | (3 << 13)); }
#pragma unroll
        for (int it = 0; it < 16; ++it) { const int m = ms[it]; const unsigned long long bal = __ballot(m >= 0);
            if (m >= 0) { const int idx = 256 + base + __popcll(bal & ((1ull << lane) - 1ull)); if (idx >= lo && idx < hi) list[idx - lo] = (unsigned short)((wbase + it * 64 + lane) | (m << 13)); }
            base += __popcll(bal); }
        __syncthreads();
        constexpr int NQT = 1; const int nb = (L + 16 * NQT - 1) / (16 * NQT);
        for (int b = wave; b < nb; b += 8) {
            int tq[NQT], slot[NQT]; bool valid[NQT]; bf16x8 qf[NQT][4];
#pragma unroll
            for (int qt = 0; qt < NQT; ++qt) { const int qi = b * (16 * NQT) + qt * 16 + fr; valid[qt] = qi < L; const unsigned e = list[valid[qt] ? qi : 0]; tq[qt] = e & 8191; slot[qt] = e >> 13;
                const bf16* qp = P1 + (size_t)tq[qt] * LD1 + C_MQ + h * 128 + g * 8;
#pragma unroll
                for (int ks = 0; ks < 4; ++ks) qf[qt][ks] = *(const GAS bf16x8*)(qp + ks * 32); }
            f32x4 sa[NQT][16]; const float z = opaque_zero();
#pragma unroll
            for (int qt = 0; qt < NQT; ++qt)
#pragma unroll
                for (int kt = 0; kt < 16; ++kt) sa[qt][kt] = (f32x4){z, z, z, z};
            { bf16x8 kf[4];
#pragma unroll
              for (int ks = 0; ks < 4; ++ks) kf[ks] = *(const LAS bf16x8*)(Ks + fr * 136 + ks * 32 + g * 8);
#pragma unroll
              for (int kt = 0; kt < 16; ++kt) { bf16x8 kn[4];
#pragma unroll
                  for (int ks = 0; ks < 4; ++ks) kn[ks] = *(const LAS bf16x8*)(Ks + (((kt + 1) & 15) * 16 + fr) * 136 + ks * 32 + g * 8);
#pragma unroll
                  for (int ks = 0; ks < 4; ++ks) { _Pragma("unroll") for (int qt = 0; qt < NQT; ++qt) MFMA_PIN(sa[qt][kt], kf[ks], qf[qt][ks]); }
                  __builtin_amdgcn_sched_barrier(0);
#pragma unroll
                  for (int ks = 0; ks < 4; ++ks) kf[ks] = kn[ks]; } }
            bf16x8 pf[NQT][8]; float mrow[NQT], lrow[NQT];
#pragma unroll
            for (int qt = 0; qt < NQT; ++qt) {
                const float sc2 = 0.08838834764831845f * 1.4426950408889634f; const int tloc = tq[qt] - j * 256; const bool own = slot[qt] == 3;
                float mx = -3.0e38f;
#pragma unroll
                for (int kt = 0; kt < 16; ++kt)
#pragma unroll
                    for (int r = 0; r < 4; ++r) { float x = sa[qt][kt][r] * sc2; if (own && (kt * 16 + 4 * g + r) > tloc) x = -1.0e30f; sa[qt][kt][r] = x; mx = fmaxf(mx, x); }
                mx = fmaxf(mx, __shfl_xor(mx, 16)); mx = fmaxf(mx, __shfl_xor(mx, 32));
                float sum = 0.f;
#pragma unroll
                for (int kt = 0; kt < 16; ++kt)
#pragma unroll
                    for (int r = 0; r < 4; ++r) { const float p = __builtin_amdgcn_exp2f(sa[qt][kt][r] - mx); sa[qt][kt][r] = p; sum += p; }
                sum += __shfl_xor(sum, 16); sum += __shfl_xor(sum, 32);
                mrow[qt] = mx; lrow[qt] = sum;
#pragma unroll
                for (int kk = 0; kk < 8; ++kk) { u32x4 pw; pw.x = pk2(sa[qt][2 * kk][0], sa[qt][2 * kk][1]); pw.y = pk2(sa[qt][2 * kk][2], sa[qt][2 * kk][3]);
                    pw.z = pk2(sa[qt][2 * kk + 1][0], sa[qt][2 * kk + 1][1]); pw.w = pk2(sa[qt][2 * kk + 1][2], sa[qt][2 * kk + 1][3]); pf[qt][kk] = __builtin_bit_cast(bf16x8, pw); }
            }
            f32x4 oa[NQT][8];
#pragma unroll
            for (int qt = 0; qt < NQT; ++qt)
#pragma unroll
                for (int dt = 0; dt < 8; ++dt) oa[qt][dt] = (f32x4){z, z, z, z};
#define MOBA_LDV(dst, st) do { _Pragma("unroll") for (int q4 = 0; q4 < 4; ++q4) { const LAS bf16* vp = Vt + ((((st) >> 1) & 7) * 16 + fr) * 264 + (((st) & 1) * 4 + q4) * 32 + 4 * g; \
                const u32x2 vlo = *(const LAS u32x2*)vp, vhi = *(const LAS u32x2*)(vp + 16); dst[q4] = __builtin_bit_cast(bf16x8, (u32x4){vlo.x, vlo.y, vhi.x, vhi.y}); } } while (0)
            { bf16x8 vf[4]; MOBA_LDV(vf, 0);
#pragma unroll
              for (int st = 0; st < 16; ++st) { bf16x8 vn[4]; MOBA_LDV(vn, st + 1);
#pragma unroll
                  for (int q4 = 0; q4 < 4; ++q4) { _Pragma("unroll") for (int qt = 0; qt < NQT; ++qt) MFMA_PIN(oa[qt][st >> 1], vf[q4], pf[qt][(st & 1) * 4 + q4]); }
                  __builtin_amdgcn_sched_barrier(0);
#pragma unroll
                  for (int q4 = 0; q4 < 4; ++q4) vf[q4] = vn[q4]; } }
#undef MOBA_LDV
#pragma unroll
            for (int qt = 0; qt < NQT; ++qt) if (valid[qt]) {
                const size_t e = ((size_t)tq[qt] * 8 + h) * 4 + slot[qt]; const float il = 1.0f / lrow[qt];
#pragma unroll
                for (int dt = 0; dt < 8; ++dt) { u32x2 o; o.x = pk2(oa[qt][dt][0] * il, oa[qt][dt][1] * il); o.y = pk2(oa[qt][dt][2] * il, oa[qt][dt][3] * il); *(g_u32x2*)(OPART + e * 128 + dt * 16 + 4 * g) = o; }
                if (g == 0) { ML[2 * e] = mrow[qt]; ML[2 * e + 1] = lrow[qt]; }
            }
        }
    }
}
__device__ __forceinline__ void moba_combine(const bf16* OPART, const float* ML, bf16* OMOBA, const int gw, const int ngw, const int lane) {
    for (int it = gw; it < NT * 8; it += ngw) {
        const int t = it >> 3, h = it & 7, own = t >> 8, nsel = own < 3 ? own : 3; const size_t e0 = (size_t)it * 4;
        float m[4], l[4]; float M = -3.0e38f;
#pragma unroll
        for (int s = 0; s < 4; ++s) { const bool v = (s == 3) || (s < nsel); m[s] = v ? ML[2 * (e0 + s)] : -3.0e38f; l[s] = v ? ML[2 * (e0 + s) + 1] : 0.f; M = fmaxf(M, m[s]); }
        float o0 = 0.f, o1 = 0.f, W = 0.f;
#pragma unroll
        for (int s = 0; s < 4; ++s) { const bool v = (s == 3) || (s < nsel); if (v) { const float w = l[s] * __builtin_amdgcn_exp2f(m[s] - M); W += w;
            const unsigned ow = *(const GAS unsigned*)(OPART + (e0 + s) * 128 + 2 * lane); o0 += w * bflo(ow); o1 += w * bfhi(ow); } }
        const float iw = 1.0f / W;
        *(GAS unsigned*)(OMOBA + (size_t)t * 1024 + h * 128 + 2 * lane) = pk2(o0 * iw, o1 * iw);
    }
}

#define PG_ROWGROUPS(ROWV, ...) _Pragma("unroll") for (int _ai = 0; _ai < 2; ++_ai) _Pragma("unroll") for (int _m = 0; _m < 4; ++_m) { const int ROWV = _ai * 128 + wr * 64 + _m * 16 + fr; __VA_ARGS__ asm volatile("" ::: "memory"); }
#define PG_CHUNKS(J, COLV, ...) _Pragma("unroll") for (int _bj = 0; _bj < 2; ++_bj) _Pragma("unroll") for (int _n = 0; _n < 2; ++_n) { const int J = _bj * 2 + _n; const int COLV = _bj * 128 + wc * 32 + _n * 16 + fq * 4; __VA_ARGS__ }
#define PG_ACC(acc) acc[_ai][_bj][_m][_n]
struct EpiA1 {
    bf16* P1; const float* ROPE; const float* bgate;
    __device__ __forceinline__ void operator()(const f32x4 (&acc)[2][2][4][2], const pg8::Unit& u, int wr, int wc, int fr, int fq) const {
        const int row0 = u.pm * 256, col0 = u.pn * 256;
        if (col0 < C_MV) {
            PG_ROWGROUPS(r, { const int row = row0 + r; f32x4 cs[4];
                PG_CHUNKS(j, c, { cs[j] = *(const g_f32x4*)(ROPE + ((size_t)row * 64 + (((col0 + c) & 127) >> 1)) * 2); })
                PG_CHUNKS(j, c, { const f32x4 v = PG_ACC(acc); u32x2 o; o.x = pk2(v.x * cs[j].x - v.y * cs[j].y, v.y * cs[j].x + v.x * cs[j].y); o.y = pk2(v.z * cs[j].z - v.w * cs[j].w, v.w * cs[j].z + v.z * cs[j].w);
                    *(g_u32x2*)(P1 + (size_t)row * LD1 + col0 + c) = o; }) })
        } else if (col0 >= C_GATE) {
            f32x4 b[4];
            { const int _ai = 0, _m = 0; (void)_ai; (void)_m; PG_CHUNKS(j, c, { b[j] = *(const g_f32x4*)(bgate + col0 + c - C_GATE); }) }
            PG_ROWGROUPS(r, { const int row = row0 + r;
                PG_CHUNKS(j, c, { const f32x4 v = PG_ACC(acc); u32x2 o; o.x = pk2(sigmoidf_(v.x + b[j].x), sigmoidf_(v.y + b[j].y)); o.y = pk2(sigmoidf_(v.z + b[j].z), sigmoidf_(v.w + b[j].w));
                    *(g_u32x2*)(P1 + (size_t)row * LD1 + col0 + c) = o; }) })
        } else {
            PG_ROWGROUPS(r, { const int row = row0 + r;
                PG_CHUNKS(j, c, { const f32x4 v = PG_ACC(acc); u32x2 o; o.x = pk2(v.x, v.y); o.y = pk2(v.z, v.w); *(g_u32x2*)(P1 + (size_t)row * LD1 + col0 + c) = o; }) })
        }
    }
};
struct BranchSched {
    const bf16* A0; const bf16* A1; const bf16* A2; const bf16* Bt; int lda, ldb, G, c;
    __device__ __forceinline__ bool next(int i, pg8::Unit& u) const { const int tile = c + (i / 3) * G; if (tile >= 256) return false; u.pm = tile >> 3; u.pn = tile & 7; u.x = i % 3; u.y = 0; return true; }
    __device__ __forceinline__ const char* abase(const pg8::Unit& u) const { const bf16* a = u.x == 0 ? A0 : (u.x == 1 ? A1 : A2); return (const char*)(a + (size_t)u.pm * 256 * lda); }
    __device__ __forceinline__ const char* bbase(const pg8::Unit& u) const { return (const char*)(Bt + (size_t)u.x * DM * 1024 + (size_t)u.pn * 256 * ldb); }
    __device__ __forceinline__ unsigned avoff(const pg8::Unit&, int R, int C, int h) const { return (unsigned)((h * 128 + R) * lda + C) * 2u; }
};
struct EpiA5 {
    const bf16* P1; float* MF; bf16* MERGED;
    __device__ __forceinline__ void operator()(const f32x4 (&acc)[2][2][4][2], const pg8::Unit& u, int wr, int wc, int fr, int fq) const {
        const int row0 = u.pm * 256, col0 = u.pn * 256; const int n = u.x;
        PG_ROWGROUPS(r, { const int row = row0 + r; u32x2 gg[4]; f32x4 mf[4];
            PG_CHUNKS(j, c, { gg[j] = *(const g_u32x2*)(P1 + (size_t)row * LD1 + C_GATE + n * DM + col0 + c); mf[j] = (f32x4){0.f, 0.f, 0.f, 0.f}; if (n > 0) mf[j] = *(const g_f32x4*)(MF + (size_t)row * DM + col0 + c); })
            PG_CHUNKS(j, c, { const f32x4 v = PG_ACC(acc); const f32x4 o = (f32x4){mf[j].x + bflo(gg[j].x) * v.x, mf[j].y + bfhi(gg[j].x) * v.y, mf[j].z + bflo(gg[j].y) * v.z, mf[j].w + bfhi(gg[j].y) * v.w};
                if (n < 2) *(g_f32x4*)(MF + (size_t)row * DM + col0 + c) = o; else { u32x2 ob; ob.x = pk2(o.x, o.y); ob.y = pk2(o.z, o.w); *(g_u32x2*)(MERGED + (size_t)row * DM + col0 + c) = ob; } }) })
    }
};
struct EpiResid {
    const float* xin; float* xout;
    __device__ __forceinline__ void operator()(const f32x4 (&acc)[2][2][4][2], const pg8::Unit& u, int wr, int wc, int fr, int fq) const {
        const int row0 = u.pm * 256, col0 = u.pn * 256;
        PG_ROWGROUPS(r, { const size_t ro = (size_t)(row0 + r) * DM + col0; f32x4 xi[4];
            PG_CHUNKS(j, c, { xi[j] = *(const g_f32x4*)(xin + ro + c); })
            PG_CHUNKS(j, c, { *(g_f32x4*)(xout + ro + c) = xi[j] + PG_ACC(acc); }) })
    }
};
struct EpiBf16 {
    bf16* out; int ldo;
    __device__ __forceinline__ void operator()(const f32x4 (&acc)[2][2][4][2], const pg8::Unit& u, int wr, int wc, int fr, int fq) const {
        const int row0 = u.pm * 256, col0 = u.pn * 256;
        PG_ROWGROUPS(r, { PG_CHUNKS(j, c, { const f32x4 v = PG_ACC(acc); u32x2 o; o.x = pk2(v.x, v.y); o.y = pk2(v.z, v.w); *(g_u32x2*)(out + (size_t)(row0 + r) * ldo + col0 + c) = o; }) })
    }
};
struct MoeSched {
    const bf16* A; const bf16* Bt; int lda, ldb; size_t bstride; int nct, G, c, gather; const int* TOKOF; const LAS int* mtile; const LAS int* mcnt;
    __device__ __forceinline__ bool next(int i, pg8::Unit& u) const {
        const int idx = i * G + c; if (idx >= mtile[NEXP] * nct) return false;
        const int rtg = idx / nct; int e = 0;
        for (int j = 1; j < NEXP; ++j) if (mtile[j] <= rtg) e = j;
        u.pm = rtg; u.pn = idx % nct; u.x = e; u.y = (rtg - mtile[e]) * TMOE; return true; }
    __device__ __forceinline__ const char* abase(const pg8::Unit& u) const { return gather ? (const char*)A : (const char*)(A + (size_t)u.pm * 256 * lda); }
    __device__ __forceinline__ const char* bbase(const pg8::Unit& u) const { return (const char*)(Bt + (size_t)u.x * bstride + (size_t)u.pn * 256 * ldb); }
    __device__ __forceinline__ unsigned avoff(const pg8::Unit& u, int R, int C, int h) const {
        if (!gather) return (unsigned)((h * 128 + R) * lda + C) * 2u;
        const int rk = u.y + h * 128 + R; const int tok = rk < mcnt[u.x] ? TOKOF[u.x * NT + rk] : 0; return (unsigned)(tok * lda + C) * 2u; }
};
struct EpiMoe1 {
    bf16* ACT;
    __device__ __forceinline__ void operator()(const f32x4 (&acc)[2][2][4][2], const pg8::Unit& u, int wr, int wc, int fr, int fq) const {
        const int row0 = u.pm * 256, col0 = u.pn * 256;
        PG_ROWGROUPS(r, { PG_CHUNKS(j, c, { const f32x4 v = PG_ACC(acc);
            *(GAS unsigned*)(ACT + (size_t)(row0 + r) * DFF + ((col0 + c) >> 1)) = pk2(v.x * sigmoidf_(v.x) * v.y, v.z * sigmoidf_(v.z) * v.w); }) })
    }
};

__device__ __forceinline__ float rbias(const float* brg, const float* bre, int col) { return col < 8 ? brg[col] : (col < 72 ? bre[col - 8] : 0.f); }
struct Args { const void* in[28]; float* out; unsigned char* ws; int ph_lo, ph_hi; };
enum { I_X = 0, I_MEM, I_POS, I_NORM_MIX, I_W_IN, I_W_GLA_DECAY, I_B_GLA_DECAY, I_GLA_NORM, I_W_POOL, I_POOL_SCALE, I_W_BRANCH, I_W_GATE, I_B_GATE, I_W_MIX_OUT,
       I_NORM_XATTN, I_NORM_MEM, I_W_XQ, I_W_XKV, I_W_XO, I_NORM_MOE, I_W_RG, I_B_RG, I_W_RE, I_B_RE, I_W_EG, I_W_EU, I_W_ED, I_NORM_FINAL };

static_assert(sizeof(Args) == 248 && __builtin_offsetof(Args, out) == 224 && __builtin_offsetof(Args, ws) == 232, "kernarg layout");
constexpr int NPH_PRE = 2, NPH_LAYER = 18, NPH = NPH_PRE + NLAYER * NPH_LAYER;

__device__ __forceinline__ void row_prep(const float* xr, bf16* xb, float* rstd_out, int lane) {
    float ss = 0.f; f32x4 v[8];
#pragma unroll
    for (int j = 0; j < 8; ++j) { v[j] = ((const f32x4*)xr)[lane + 64 * j]; ss += (v[j].x * v[j].x + v[j].y * v[j].y) + (v[j].z * v[j].z + v[j].w * v[j].w); }
    ss = wave_sum(ss); const float rs = 1.0f / sqrtf(ss * (1.0f / DM) + EPS);
#pragma unroll
    for (int j = 0; j < 8; ++j) { u32x2 o; o.x = pk2(v[j].x * rs, v[j].y * rs); o.y = pk2(v[j].z * rs, v[j].w * rs); ((u32x2*)xb)[lane + 64 * j] = o; }
    if (lane == 0) *rstd_out = rs;
}

#define PTRS() unsigned char* wsl = ws; asm volatile("" : "+s"(wsl)); \
    const void* const* kin = (const void* const*)__builtin_amdgcn_kernarg_segment_ptr(); asm volatile("" : "+s"(kin)); \
    int tid = tid0; asm volatile("" : "+v"(tid)); int bid = bid0; asm volatile("" : "+s"(bid)); \
    const int lane = tid & 63, wave = __builtin_amdgcn_readfirstlane(tid >> 6), G = gridDim.x; \
    const int gw = bid * 8 + wave, ngw = G * 8, gt = bid * 512 + tid, ngt = G * 512; (void)gw; (void)ngw; (void)gt; (void)ngt; (void)lane; (void)kin; \
    float* ROPE = (float*)(wsl + WS_ROPE); \
    float* RSTD = (float*)(wsl + WS_RSTD); \
    float* RSTDM = (float*)(wsl + WS_RSTDM); \
    float* KMEAN = (float*)(wsl + WS_KMEAN); \
    bf16* MB = (bf16*)(wsl + WS_MB); \
    int* ROUTE = (int*)(wsl + WS_ROUTE); \
    float* GDEC = (float*)(wsl + WS_GDEC); \
    float* LOGITS = (float*)(wsl + WS_LOGITS); \
    int* TOKOF = (int*)(wsl + WS_TOKOF); \
    float* XF = (float*)(wsl + WS_XF); \
    bf16* XB = (bf16*)(wsl + WS_XB); \
    bf16* P1 = (bf16*)(wsl + WS_P1); \
    bf16* OMOBA = (bf16*)(wsl + WS_OMOBA); \
    bf16* OGLA = (bf16*)(wsl + WS_OGLA); \
    bf16* MIXED = (bf16*)(wsl + WS_MIXED); \
    bf16* OPOOL = (bf16*)(wsl + WS_OPOOL); \
    bf16* QDEC = (bf16*)(wsl + WS_QDEC); \
    float* OINTRA = (float*)(wsl + WS_OINTRA); \
    float* GKV = (float*)(wsl + WS_GKV); \
    bf16* MERGED = (bf16*)(wsl + WS_MERGED); \
    bf16* XQ = (bf16*)(wsl + WS_XQ); \
    bf16* XO = (bf16*)(wsl + WS_XO); \
    float* MF = (float*)(wsl + WS_MF); \
    int* SEL = (int*)(wsl + WS_SEL); \
    float* ML = (float*)(wsl + WS_ML); \
    bf16* OPART = (bf16*)(wsl + WS_OPART); \
    bf16* ACT = (bf16*)(wsl + WS_ACT); \
    bf16* YB = (bf16*)(wsl + WS_Y);
__global__ void __launch_bounds__(512, 2) mk_fwd(Args a) {
    extern __shared__ __attribute__((aligned(16))) unsigned char lds_raw[];
    LAS unsigned char* lds = (LAS unsigned char*)lds_raw;
    const int tid0 = threadIdx.x, bid0 = blockIdx.x;
    unsigned char* ws = a.ws;
    unsigned* ctl = (unsigned*)(ws + WS_CTL);
    volatile LAS unsigned* MISC = (volatile LAS unsigned*)(lds + MISC_OFF);
    if (tid0 < 64) MISC[tid0] = 0u;
    __syncthreads();
    XcdBarrier bar; bar.bar = ctl + CW_BAR; bar.x = 0; bar.st = nullptr;
#if MK_ONE_LAUNCH
    bar = xcd_barrier_post(ctl + CW_BAR, MISC + 8);
#endif
    const int lo = a.ph_lo, hi = a.ph_hi;
#ifndef PH_MASK
#define PH_MASK 0xfffffu
#endif
#define PHON(j) (((PH_MASK) >> (j)) & 1u)
#define IN(k) (lo <= (k) && (k) < hi)
#define SEAM(k) do { if (IN(k) && IN((k) + 1)) xcd_barrier(bar); } while (0)

    if (PHON(18) && IN(0)) { PTRS();
        LAS float* scr = (LAS float*)(lds + wave * 8448);
        for (int l = 0; l < NLAYER; ++l) {
            unsigned char* wl = ws + WS_WL + (size_t)l * WL_SIZE;
            bf16* W1T = (bf16*)(wl + WL_W1T);
            const float* nmix = (const float*)kin[I_NORM_MIX] + l * DM;
            const float* w_in = (const float*)kin[I_W_IN] + (size_t)l * DM * INW;
            transpose_mat(w_in, INW, DM, 6144, W1T, DM, nmix, MapRope{}, scr, gw, ngw, lane);
            transpose_mat(w_in + 6160, INW, DM, 1024, W1T, DM, nmix, MapOff{C_PU}, scr, gw, ngw, lane);
            transpose_small(w_in + 6144, INW, DM, 16, W1T, DM, C_GLOW, nmix, gt, ngt);
            for (int i = gt; i < (C_GATE - C_GLOW - 16) * DM / 8; i += ngt) ((u32x4*)(W1T + (size_t)(C_GLOW + 16) * DM))[i] = (u32x4){0u, 0u, 0u, 0u};
            transpose_mat((const float*)kin[I_W_GATE] + (size_t)l * DM * GATEW, GATEW, DM, GATEW, W1T, DM, nmix, MapOff{C_GATE}, scr, gw, ngw, lane);
            for (int n = 0; n < 3; ++n)
                transpose_mat((const float*)kin[I_W_BRANCH] + ((size_t)l * 3 + n) * 1024 * DM, DM, 1024, DM, (bf16*)(wl + WL_WBRT) + (size_t)n * DM * 1024, 1024, nullptr, MapOff{0}, scr, gw, ngw, lane);
            for (int g = 0; g < 4; ++g)
                transpose_mat((const float*)kin[I_W_POOL] + ((size_t)l * 4 + g) * 256 * 256, 256, 256, 256, (bf16*)(wl + WL_WPOOLT) + (size_t)g * 256 * 256, 256, nullptr, MapOff{0}, scr, gw, ngw, lane);
            transpose_mat((const float*)kin[I_W_MIX_OUT] + (size_t)l * DM * DM, DM, DM, DM, (bf16*)(wl + WL_WMIXT), DM, nullptr, MapOff{0}, scr, gw, ngw, lane);
            transpose_mat((const float*)kin[I_W_XQ] + (size_t)l * DM * 512, 512, DM, 512, (bf16*)(wl + WL_WXQT), DM, (const float*)kin[I_NORM_XATTN] + l * DM, MapOff{0}, scr, gw, ngw, lane);
            transpose_mat((const float*)kin[I_W_XKV] + (size_t)l * DM * 1024, 1024, DM, 1024, (bf16*)(wl + WL_WXKVT), DM, (const float*)kin[I_NORM_MEM] + l * DM, MapOff{0}, scr, gw, ngw, lane);
            transpose_mat((const float*)kin[I_W_XO] + (size_t)l * 512 * DM, DM, 512, DM, (bf16*)(wl + WL_WXOT), 512, nullptr, MapOff{0}, scr, gw, ngw, lane);
            const float* nmoe = (const float*)kin[I_NORM_MOE] + l * DM;
            bf16* WRT = (bf16*)(wl + WL_WRT);
            transpose_small((const float*)kin[I_W_RG] + (size_t)l * DM * 8, 8, DM, 8, WRT, DM, 0, nmoe, gt, ngt);
            transpose_small((const float*)kin[I_W_RE] + (size_t)l * DM * 64, 64, DM, 64, WRT, DM, 8, nmoe, gt, ngt);
            for (int i = gt; i < (128 - 72) * DM / 8; i += ngt) ((u32x4*)(WRT + (size_t)72 * DM))[i] = (u32x4){0u, 0u, 0u, 0u};
            for (int e = 0; e < NEXP; ++e) {
                bf16* W13 = (bf16*)(wl + WL_W13T) + (size_t)e * 1024 * DM;
                transpose_mat((const float*)kin[I_W_EG] + ((size_t)l * NEXP + e) * DM * DFF, DFF, DM, DFF, W13, DM, nmoe, MapIl{0}, scr, gw, ngw, lane);
                transpose_mat((const float*)kin[I_W_EU] + ((size_t)l * NEXP + e) * DM * DFF, DFF, DM, DFF, W13, DM, nmoe, MapIl{1}, scr, gw, ngw, lane);
                transpose_mat((const float*)kin[I_W_ED] + ((size_t)l * NEXP + e) * DFF * DM, DM, DFF, DM, (bf16*)(wl + WL_W2T) + (size_t)e * DM * DFF, DFF, nullptr, MapOff{0}, scr, gw, ngw, lane);
            }
        }
        for (int i = gt; i < NT * 64; i += ngt) {
            const int t = i >> 6, f = i & 63;
            const float inv = 1.0f / powf(10000.0f, (float)(2 * f) / 128.0f);
            const float ang = (float)((const int*)kin[I_POS])[t] * inv;
            double r = (double)ang * 0.15915494309189533577; r -= floor(r + 0.5); r *= 6.28318530717958647692;
            const double r2 = r * r; double ts = r, tc = 1.0, s = r, c = 1.0;
#pragma unroll 1
            for (int n = 1; n <= 14; ++n) { tc *= -r2 / (double)((2 * n - 1) * (2 * n)); ts *= -r2 / (double)((2 * n) * (2 * n + 1)); c += tc; s += ts; }
            ROPE[2 * i] = (float)c; ROPE[2 * i + 1] = (float)s;
        }
        for (int t = gw; t < NT; t += ngw) row_prep((const float*)kin[I_X] + (size_t)t * DM, XB + (size_t)t * DM, RSTD + t, lane);
        for (int t = gw; t < MEMLEN; t += ngw) row_prep((const float*)kin[I_MEM] + (size_t)t * DM, MB + (size_t)t * DM, RSTDM + t, lane);
    }
    SEAM(0);
    if (PHON(19) && IN(1)) { PTRS();
        for (int u = bid; u < NLAYER * 2 * 8; u += G) {
            const int l = u >> 4, rt = (u >> 3) & 1, ct = u & 7;
            const bf16* Bt = (const bf16*)(ws + WS_WL + (size_t)l * WL_SIZE + WL_WXKVT) + (size_t)ct * 128 * DM;
            f32x4 acc[2][4]; sg_zero(acc);
            sg_tile(lds, MB + (size_t)rt * 128 * DM, DM, Bt, DM, DM, acc, tid);
            bf16* KVM = (bf16*)(ws + WS_KVM) + (size_t)l * MEMLEN * 1024;
            SG_FOREACH(acc, r, c, v, { const int row = rt * 128 + r, col = ct * 128 + c;
                u32x2 o; o.x = pk2(v.x, v.y); o.y = pk2(v.z, v.w); *(u32x2*)(KVM + (size_t)row * 1024 + col) = o; });
        }
    }
    SEAM(1);

    for (int l = 0; l < NLAYER; ++l) {
        const int pb = NPH_PRE + l * NPH_LAYER;
        unsigned char* wl = ws + WS_WL + (size_t)l * WL_SIZE;
        if (PHON(0) && IN(pb + 0)) { PTRS();
            pg8::PlainSched S; S.A = XB; S.Bt = (const bf16*)(wl + WL_W1T); S.lda = DM; S.ldb = DM; S.ord.init(NT / 256, LD1 / 256, G, bid);
            EpiA1 E; E.P1 = P1; E.ROPE = ROPE; E.bgate = (const float*)kin[I_B_GATE] + l * GATEW;
            pg8::gemm_phase(lds, S, E, DM, tid);
        }
        SEAM(pb + 0);
        if (PHON(1) && IN(pb + 1)) { PTRS();
            for (int u = bid; u < 8 * 32; u += G) {
                const int h = u >> 5, blk = u & 31, d = tid & 127, part = tid >> 7;
                float s = 0.f;
                for (int r = 0; r < 64; ++r) s += bf2f(P1[(size_t)(blk * 256 + part * 64 + r) * LD1 + C_MK + h * 128 + d]);
                LAS float* red = (LAS float*)lds;
                __syncthreads(); red[tid] = s; __syncthreads();
                if (tid < 128) KMEAN[(h * 32 + blk) * 128 + tid] = (red[tid] + red[tid + 128] + red[tid + 256] + red[tid + 384]) * (1.0f / 256.0f);
            }
            __syncthreads();
            {
                LAS float* sb = (LAS float*)lds;
                LAS float* sq = (LAS float*)(lds + 32768);
                LAS float* sk = (LAS float*)(lds + 32768 + 33792);
                LAS bf16* sv = (LAS bf16*)(lds + 32768 + 2 * 33792);
                LAS float* sg = (LAS float*)(lds + 32768 + 2 * 33792 + 32768);
                LAS float* sdl = (LAS float*)(lds + 32768 + 2 * 33792 + 32768 + 4096);
                const float* wdec = (const float*)kin[I_W_GLA_DECAY] + (size_t)l * 16 * 512;
                const float* bdec = (const float*)kin[I_B_GLA_DECAY] + l * 512;
                for (int u = bid; u < 4 * 128; u += G) {
                    const int h = u >> 7, ch = u & 127, t0 = ch * 64;
                    __syncthreads();
                    for (int i = tid; i < 64 * 16; i += 512) sg[i] = bf2f(P1[(size_t)(t0 + (i >> 4)) * LD1 + C_GLOW + (i & 15)]);
                    for (int i = tid; i < 64 * 32; i += 512) { const int c = i >> 5, e8 = i & 31; *(LAS u32x4*)(sv + c * 256 + e8 * 8) = *(const u32x4*)(P1 + (size_t)(t0 + c) * LD1 + C_GV + h * 256 + e8 * 8); }
                    __syncthreads();
                    if (tid < 128) {
                        const int d = tid; float w[16];
#pragma unroll
                        for (int r = 0; r < 16; ++r) w[r] = wdec[r * 512 + h * 128 + d];
                        const float b0 = bdec[h * 128 + d]; float cum = 0.f;
                        for (int c = 0; c < 64; ++c) { float z = b0;
#pragma unroll
                            for (int r = 0; r < 16; ++r) z += sg[c * 16 + r] * w[r];
                            const float ls = fminf(z, 0.f) - log1pf(__expf(-fabsf(z)));
                            cum += ls * (1.0f / 16.0f); sb[c * 128 + d] = cum; }
                        GDEC[u * 128 + d] = __expf(cum); sdl[d] = __expf(cum);
                    }
                    __syncthreads();
                    for (int i = tid; i < 64 * 128; i += 512) { const int c = i >> 7, d = i & 127; const float b = sb[i];
                        const float q = bf2f(P1[(size_t)(t0 + c) * LD1 + C_GQ + h * 128 + d]) * 0.08838834764831845f * __expf(b);
                        const float k = bf2f(P1[(size_t)(t0 + c) * LD1 + C_GK + h * 128 + d]) * __expf(-b);
                        sq[c * 132 + d] = q; sk[c * 132 + d] = k; QDEC[(size_t)(t0 + c) * 512 + h * 128 + d] = (bf16)(pk2(q, 0.f) & 0xffffu); }
                    __syncthreads();
                    { const int c = tid >> 3, jg = tid & 7; float at[8];
#pragma unroll
                        for (int jj = 0; jj < 8; ++jj) at[jj] = 0.f;
                        for (int d = 0; d < 128; d += 4) { const f32x4 qv = *(const LAS f32x4*)(sq + c * 132 + d);
#pragma unroll
                            for (int jj = 0; jj < 8; ++jj) { const f32x4 kv = *(const LAS f32x4*)(sk + (jg + 8 * jj) * 132 + d); at[jj] += (qv.x * kv.x + qv.y * kv.y) + (qv.z * kv.z + qv.w * kv.w); } }
#pragma unroll
                        for (int jj = 0; jj < 8; ++jj) { const int j = jg + 8 * jj; sb[c * 64 + j] = (j <= c) ? at[jj] : 0.f; } }
                    __syncthreads();
                    { const int c = tid >> 3, e0 = (tid & 7) * 32; float o[32];
#pragma unroll
                        for (int i = 0; i < 32; ++i) o[i] = 0.f;
                        for (int j = 0; j <= c; ++j) { const float aw = sb[c * 64 + j];
#pragma unroll
                            for (int q4 = 0; q4 < 4; ++q4) { const u32x4 vv = *(const LAS u32x4*)(sv + j * 256 + e0 + q4 * 8);
                                o[q4 * 8 + 0] += aw * bflo(vv.x); o[q4 * 8 + 1] += aw * bfhi(vv.x); o[q4 * 8 + 2] += aw * bflo(vv.y); o[q4 * 8 + 3] += aw * bfhi(vv.y);
                                o[q4 * 8 + 4] += aw * bflo(vv.z); o[q4 * 8 + 5] += aw * bfhi(vv.z); o[q4 * 8 + 6] += aw * bflo(vv.w); o[q4 * 8 + 7] += aw * bfhi(vv.w); } }
                        float* op = OINTRA + (size_t)(t0 + c) * 1024 + h * 256 + e0;
#pragma unroll
                        for (int i = 0; i < 32; i += 4) *(f32x4*)(op + i) = (f32x4){o[i], o[i + 1], o[i + 2], o[i + 3]}; }
                    { const int d0 = (tid >> 5) * 8, e0 = (tid & 31) * 8; float kv[8][8];
#pragma unroll
                        for (int i = 0; i < 8; ++i)
#pragma unroll
                            for (int j = 0; j < 8; ++j) kv[i][j] = 0.f;
                        for (int c = 0; c < 64; ++c) { const f32x4 k0 = *(const LAS f32x4*)(sk + c * 132 + d0), k1 = *(const LAS f32x4*)(sk + c * 132 + d0 + 4);
                            const u32x4 vv = *(const LAS u32x4*)(sv + c * 256 + e0);
                            const float kk[8] = {k0.x, k0.y, k0.z, k0.w, k1.x, k1.y, k1.z, k1.w};
                            const float ve[8] = {bflo(vv.x), bfhi(vv.x), bflo(vv.y), bfhi(vv.y), bflo(vv.z), bfhi(vv.z), bflo(vv.w), bfhi(vv.w)};
#pragma unroll
                            for (int i = 0; i < 8; ++i)
#pragma unroll
                                for (int j = 0; j < 8; ++j) kv[i][j] += kk[i] * ve[j]; }
#pragma unroll
                        for (int i = 0; i < 8; ++i) { const float dl = sdl[d0 + i];
                            float* gp = GKV + ((size_t)u * 128 + d0 + i) * 256 + e0;
                            *(f32x4*)gp = (f32x4){kv[i][0] * dl, kv[i][1] * dl, kv[i][2] * dl, kv[i][3] * dl}; *(f32x4*)(gp + 4) = (f32x4){kv[i][4] * dl, kv[i][5] * dl, kv[i][6] * dl, kv[i][7] * dl}; } }
                }
            }
            for (int i = gt; i < NT * 128; i += ngt) {
                const int t = i >> 7, c8 = (i & 127) * 8, w = 2 << (c8 >> 8);
                const int start = (t + 1 - w) > 0 ? (t + 1 - w) : 0; float s[8];
#pragma unroll
                for (int j = 0; j < 8; ++j) s[j] = 0.f;
                for (int r = start; r <= t; ++r) { const u32x4 vv = *(const u32x4*)(P1 + (size_t)r * LD1 + C_PU + c8);
                    s[0] += bflo(vv.x); s[1] += bfhi(vv.x); s[2] += bflo(vv.y); s[3] += bfhi(vv.y); s[4] += bflo(vv.z); s[5] += bfhi(vv.z); s[6] += bflo(vv.w); s[7] += bfhi(vv.w); }
                const u32x4 uu = *(const u32x4*)(P1 + (size_t)t * LD1 + C_PU + c8); const float ic = 1.0f / (float)(t + 1 - start);
                u32x4 o; o.x = pk2(s[0] * ic - bflo(uu.x), s[1] * ic - bfhi(uu.x)); o.y = pk2(s[2] * ic - bflo(uu.y), s[3] * ic - bfhi(uu.y));
                o.z = pk2(s[4] * ic - bflo(uu.z), s[5] * ic - bfhi(uu.z)); o.w = pk2(s[6] * ic - bflo(uu.w), s[7] * ic - bfhi(uu.w));
                *(u32x4*)(MIXED + (size_t)t * 1024 + c8) = o;
            }
        }
        SEAM(pb + 1);
        if (PHON(2) && IN(pb + 2)) { PTRS();
            for (int i = gt; i < 4 * 128 * 256; i += ngt) {
                const int h = i >> 15, de = i & 32767, d = de >> 8; float s = 0.f;
                float* p = GKV + (size_t)h * 128 * 32768 + de; const float* dc = GDEC + h * 128 * 128 + d;
#pragma unroll 8
                for (int n = 0; n < 128; ++n) { const float kv = p[(size_t)n * 32768]; const float dl = dc[n * 128]; p[(size_t)n * 32768] = s; s = dl * s + kv; }
            }
            {
                const float* pscale = (const float*)kin[I_POOL_SCALE] + l * 1024;
                for (int u = bid; u < 64 * 4 * 2; u += G) {
                    const int rt = u >> 3, g = (u >> 1) & 3, ct = u & 1;
                    f32x4 acc[2][4]; sg_zero(acc);
                    sg_tile(lds, MIXED + (size_t)rt * 128 * 1024 + g * 256, 1024, (const bf16*)(wl + WL_WPOOLT) + (size_t)g * 65536 + (size_t)ct * 128 * 256, 256, 256, acc, tid);
                    SG_FOREACH(acc, r, c, v, { const int row = rt * 128 + r, col = g * 256 + ct * 128 + c; const f32x4 ps = *(const f32x4*)(pscale + col);
                        u32x2 o; o.x = pk2(v.x * ps.x, v.y * ps.y); o.y = pk2(v.z * ps.z, v.w * ps.w); *(u32x2*)(OPOOL + (size_t)row * 1024 + col) = o; });
                }
                __syncthreads();
            }
            moba_gate(lds, P1, KMEAN, SEL, bid, G, tid);
        }
        SEAM(pb + 2);
        if (PHON(3) && IN(pb + 3)) { PTRS();
            moba_attn(lds, P1, SEL, OPART, ML, bid, G, tid);
            __syncthreads();
            LAS float* sq = (LAS float*)lds;
            LAS float* ss = (LAS float*)(lds + 33792);
            const float* gnorm = (const float*)kin[I_GLA_NORM] + l * 256;
            for (int u = bid; u < 4 * 128; u += G) {
                const int h = u >> 7, ch = u & 127, t0 = ch * 64; const int c = tid >> 3, eg = tid & 7;
                __syncthreads();
                for (int i = tid; i < 64 * 128; i += 512) sq[(i >> 7) * 132 + (i & 127)] = bf2f(QDEC[(size_t)(t0 + (i >> 7)) * 512 + h * 128 + (i & 127)]);
                float o[2][16];
#pragma unroll
                for (int hf = 0; hf < 2; ++hf) {
                    __syncthreads();
                    for (int i = tid; i < 128 * 32; i += 512) { const int d = i >> 5, e4 = (i & 31) * 4; *(LAS f32x4*)(ss + d * 128 + e4) = *(const f32x4*)(GKV + ((size_t)u * 128 + d) * 256 + hf * 128 + e4); }
                    __syncthreads();
                    const float* oi = OINTRA + (size_t)(t0 + c) * 1024 + h * 256 + hf * 128 + eg * 16;
#pragma unroll
                    for (int i = 0; i < 16; i += 4) { const f32x4 v = *(const f32x4*)(oi + i); o[hf][i] = v.x; o[hf][i + 1] = v.y; o[hf][i + 2] = v.z; o[hf][i + 3] = v.w; }
                    for (int d = 0; d < 128; ++d) { const float qv = sq[c * 132 + d];
#pragma unroll
                        for (int i = 0; i < 16; i += 4) { const f32x4 sv4 = *(const LAS f32x4*)(ss + d * 128 + eg * 16 + i); o[hf][i] += qv * sv4.x; o[hf][i + 1] += qv * sv4.y; o[hf][i + 2] += qv * sv4.z; o[hf][i + 3] += qv * sv4.w; } }
                }
                float sqs = 0.f;
#pragma unroll
                for (int hf = 0; hf < 2; ++hf)
#pragma unroll
                    for (int i = 0; i < 16; ++i) sqs += o[hf][i] * o[hf][i];
                sqs += __shfl_xor(sqs, 1); sqs += __shfl_xor(sqs, 2); sqs += __shfl_xor(sqs, 4);
                const float rs = 1.0f / sqrtf(sqs * (1.0f / 256.0f) + EPS);
#pragma unroll
                for (int hf = 0; hf < 2; ++hf) { const int e0 = hf * 128 + eg * 16; const bf16* grp = P1 + (size_t)(t0 + c) * LD1 + C_GR + h * 256 + e0; unsigned ow[8];
#pragma unroll
                    for (int i = 0; i < 16; i += 2) { const unsigned gw2 = *(const unsigned*)(grp + i); const float g0 = bflo(gw2), g1 = bfhi(gw2);
                        const float y0 = o[hf][i] * rs * gnorm[e0 + i] * (g0 * sigmoidf_(g0)), y1 = o[hf][i + 1] * rs * gnorm[e0 + i + 1] * (g1 * sigmoidf_(g1)); ow[i >> 1] = pk2(y0, y1); }
                    bf16* op = OGLA + (size_t)(t0 + c) * 1024 + h * 256 + e0;
                    *(u32x4*)op = (u32x4){ow[0], ow[1], ow[2], ow[3]}; *(u32x4*)(op + 8) = (u32x4){ow[4], ow[5], ow[6], ow[7]}; }
            }
        }
        SEAM(pb + 3);
        if (PHON(4) && IN(pb + 4)) { PTRS(); moba_combine(OPART, ML, OMOBA, gw, ngw, lane); }
        SEAM(pb + 4);
        if (PHON(5) && IN(pb + 5)) { PTRS();
            BranchSched S; S.A0 = OMOBA; S.A1 = OGLA; S.A2 = OPOOL; S.Bt = (const bf16*)(wl + WL_WBRT); S.lda = 1024; S.ldb = 1024; S.G = G; S.c = bid;
            EpiA5 E; E.P1 = P1; E.MF = MF; E.MERGED = MERGED;
            pg8::gemm_phase(lds, S, E, 1024, tid);
        }
        SEAM(pb + 5);
        if (PHON(6) && IN(pb + 6)) { PTRS();
            pg8::PlainSched S; S.A = MERGED; S.Bt = (const bf16*)(wl + WL_WMIXT); S.lda = DM; S.ldb = DM; S.ord.init(NT / 256, DM / 256, G, bid);
            EpiResid E; E.xin = (l == 0) ? (const float*)kin[I_X] : XF; E.xout = XF;
            pg8::gemm_phase(lds, S, E, DM, tid);
        }
        SEAM(pb + 6);
        if (PHON(7) && IN(pb + 7)) { PTRS(); for (int t = gw; t < NT; t += ngw) row_prep(XF + (size_t)t * DM, XB + (size_t)t * DM, RSTD + t, lane); }
        SEAM(pb + 7);
        if (PHON(8) && IN(pb + 8)) { PTRS();
            pg8::PlainSched S; S.A = XB; S.Bt = (const bf16*)(wl + WL_WXQT); S.lda = DM; S.ldb = DM; S.ord.init(NT / 256, 512 / 256, G, bid);
            EpiBf16 E; E.out = XQ; E.ldo = 512;
            pg8::gemm_phase(lds, S, E, DM, tid);
        }
        SEAM(pb + 8);
        if (PHON(9) && IN(pb + 9)) { PTRS();
            LAS float* qs = (LAS float*)(lds + wave * 2048);
            LAS float* ps = (LAS float*)(lds + wave * 2048 + 512);
            const bf16* KVM = (const bf16*)(ws + WS_KVM) + (size_t)l * MEMLEN * 1024;
            for (int it = gw; it < NT * 4; it += ngw) {
                const int t = it >> 2, h = it & 3;
                { const unsigned w = *(const unsigned*)(XQ + (size_t)t * 512 + h * 128 + 2 * lane); qs[2 * lane] = bflo(w); qs[2 * lane + 1] = bfhi(w); }
                asm volatile("s_waitcnt lgkmcnt(0)" ::: "memory");
                float sc[4]; float mx = -3.0e38f;
#pragma unroll
                for (int i = 0; i < 4; ++i) { const bf16* kp = KVM + (size_t)(lane + 64 * i) * 1024 + h * 128; float dsum = 0.f;
                    for (int d = 0; d < 128; d += 8) { const u32x4 kv = *(const u32x4*)(kp + d); const f32x4 q0 = *(const LAS f32x4*)(qs + d), q1 = *(const LAS f32x4*)(qs + d + 4);
                        dsum += (q0.x * bflo(kv.x) + q0.y * bfhi(kv.x)) + (q0.z * bflo(kv.y) + q0.w * bfhi(kv.y)) + (q1.x * bflo(kv.z) + q1.y * bfhi(kv.z)) + (q1.z * bflo(kv.w) + q1.w * bfhi(kv.w)); }
                    sc[i] = dsum * 0.08838834764831845f; mx = fmaxf(mx, sc[i]); }
                mx = wave_max(mx); float sum = 0.f;
#pragma unroll
                for (int i = 0; i < 4; ++i) { sc[i] = __expf(sc[i] - mx); sum += sc[i]; }
                sum = wave_sum(sum); const float inv = 1.0f / sum;
#pragma unroll
                for (int i = 0; i < 4; ++i) ps[lane + 64 * i] = sc[i] * inv;
                asm volatile("s_waitcnt lgkmcnt(0)" ::: "memory");
                float o0 = 0.f, o1 = 0.f; const bf16* vp = KVM + 512 + h * 128 + 2 * lane;
#pragma unroll 4
                for (int k = 0; k < 256; ++k) { const float p = ps[k]; const unsigned w = *(const unsigned*)(vp + (size_t)k * 1024); o0 += p * bflo(w); o1 += p * bfhi(w); }
                *(unsigned*)(XO + (size_t)t * 512 + h * 128 + 2 * lane) = pk2(o0, o1);
            }
        }
        SEAM(pb + 9);
        if (PHON(10) && IN(pb + 10)) { PTRS();
            pg8::PlainSched S; S.A = XO; S.Bt = (const bf16*)(wl + WL_WXOT); S.lda = 512; S.ldb = 512; S.ord.init(NT / 256, DM / 256, G, bid);
            EpiResid E; E.xin = XF; E.xout = XF;
            pg8::gemm_phase(lds, S, E, 512, tid);
        }
        SEAM(pb + 10);
        if (PHON(11) && IN(pb + 11)) { PTRS(); for (int t = gw; t < NT; t += ngw) row_prep(XF + (size_t)t * DM, XB + (size_t)t * DM, RSTD + t, lane); }
        SEAM(pb + 11);
        if (PHON(12) && IN(pb + 12)) { PTRS();
            const float* brg = (const float*)kin[I_B_RG] + l * 8; const float* bre = (const float*)kin[I_B_RE] + l * 64;
            for (int u = bid; u < 64; u += G) {
                f32x4 acc[2][4]; sg_zero(acc);
                sg_tile(lds, XB + (size_t)u * 128 * DM, DM, (const bf16*)(wl + WL_WRT), DM, DM, acc, tid);
                SG_FOREACH(acc, r, c, v, { const int row = u * 128 + r; f32x4 o;
                    o.x = v.x + rbias(brg, bre, c); o.y = v.y + rbias(brg, bre, c + 1); o.z = v.z + rbias(brg, bre, c + 2); o.w = v.w + rbias(brg, bre, c + 3);
                    *(f32x4*)(LOGITS + (size_t)row * 128 + c) = o; });
            }
        }
        SEAM(pb + 12);
        if (PHON(13) && IN(pb + 13)) { PTRS();
            for (int t = gt; t < NT; t += ngt) {
                const float* lg = LOGITS + (size_t)t * 128; float gl[8]; float gmax = -3.0e38f; int gi = 0;
#pragma unroll
                for (int j = 0; j < 8; ++j) { gl[j] = lg[j]; if (gl[j] > gmax) { gmax = gl[j]; gi = j; } }
                float gs = 0.f;
#pragma unroll
                for (int j = 0; j < 8; ++j) gs += __expf(gl[j] - gmax);
                const float gwt = 1.0f / gs;
                float el[8]; float m1 = -3.0e38f; int i1 = 0;
#pragma unroll
                for (int j = 0; j < 8; ++j) { el[j] = lg[8 + gi * 8 + j]; if (el[j] > m1) { m1 = el[j]; i1 = j; } }
                float m2 = -3.0e38f; int i2 = 0;
#pragma unroll
                for (int j = 0; j < 8; ++j) if (j != i1 && el[j] > m2) { m2 = el[j]; i2 = j; }
                const float p2 = __expf(m2 - m1);
                const float w1 = gwt / (1.0f + p2), w2 = gwt * p2 / (1.0f + p2);
                const int e1 = gi * 8 + i1, e2 = gi * 8 + i2;
                ROUTE[RT_EXP + 2 * t] = e1; ROUTE[RT_EXP + 2 * t + 1] = e2;
                ((float*)ROUTE)[RT_WGT + 2 * t] = w1; ((float*)ROUTE)[RT_WGT + 2 * t + 1] = w2;
            }
        }
        SEAM(pb + 13);
        LAS int* mstart = (LAS int*)(lds + MISC_OFF - 1024);
        LAS int* mtile = (LAS int*)(lds + MISC_OFF - 512);
        LAS int* mcnt = (LAS int*)(lds + MISC_OFF - 1536);
#define MOE_TABLES() do { __syncthreads(); if (tid == 0) { const int* cnt_ = ROUTE + RT_CNT + l * 64; int s_ = 0, tt_ = 0; for (int e_ = 0; e_ < NEXP; ++e_) { const int c_ = __hip_atomic_load(cnt_ + e_, __ATOMIC_RELAXED, __HIP_MEMORY_SCOPE_AGENT); \
            const int nt_ = (c_ + TMOE - 1) / TMOE; mstart[e_] = s_; mtile[e_] = tt_; mcnt[e_] = c_; s_ += nt_ * TMOE; tt_ += nt_; } mstart[NEXP] = s_; mtile[NEXP] = tt_; } __syncthreads(); } while (0)
        if (PHON(14) && IN(pb + 14)) { PTRS();
            LAS int* wc = (LAS int*)lds;
            for (int e = bid; e < NEXP; e += G) {
                int v[32]; int c = 0;
#pragma unroll
                for (int j = 0; j < 32; ++j) { v[j] = ROUTE[RT_EXP + wave * 2048 + j * 64 + lane]; c += __popcll(__ballot(v[j] == e)); }
                __syncthreads(); if (lane == 0) wc[wave] = c; __syncthreads();
                int base = 0, tot = 0;
#pragma unroll
                for (int w = 0; w < 8; ++w) { const int x = wc[w]; tot += x; if (w < wave) base += x; }
#pragma unroll
                for (int j = 0; j < 32; ++j) { const unsigned long long m = __ballot(v[j] == e);
                    if (v[j] == e) { const int rk = base + __popcll(m & ((1ull << lane) - 1ull)); const int idx = wave * 2048 + j * 64 + lane; ROUTE[RT_RANK + idx] = rk; TOKOF[e * NT + rk] = idx >> 1; }
                    base += __popcll(m); }
                if (tid == 0) ROUTE[RT_CNT + l * 64 + e] = tot;
            }
        }
        SEAM(pb + 14);
        if (PHON(15) && IN(pb + 15)) { PTRS();
            MOE_TABLES();
            MoeSched S; S.A = XB; S.Bt = (const bf16*)(wl + WL_W13T); S.lda = DM; S.ldb = DM; S.bstride = (size_t)1024 * DM; S.nct = 4; S.G = G; S.c = bid; S.gather = 1; S.TOKOF = TOKOF; S.mtile = mtile; S.mcnt = mcnt;
            EpiMoe1 E; E.ACT = ACT;
            pg8::gemm_phase(lds, S, E, DM, tid);
        }
        SEAM(pb + 15);
        if (PHON(16) && IN(pb + 16)) { PTRS();
            MOE_TABLES();
            MoeSched S; S.A = ACT; S.Bt = (const bf16*)(wl + WL_W2T); S.lda = DFF; S.ldb = DFF; S.bstride = (size_t)DM * DFF; S.nct = 8; S.G = G; S.c = bid; S.gather = 0; S.TOKOF = TOKOF; S.mtile = mtile; S.mcnt = mcnt;
            EpiBf16 E; E.out = YB; E.ldo = DM;
            pg8::gemm_phase(lds, S, E, DFF, tid);
        }
        SEAM(pb + 16);
        if (PHON(17) && IN(pb + 17)) { PTRS();
            MOE_TABLES();
            const float* nfin = (const float*)kin[I_NORM_FINAL];
            for (int t = gw; t < NT; t += ngw) {
                const int d0 = mstart[ROUTE[RT_EXP + 2 * t]] + ROUTE[RT_RANK + 2 * t], d1 = mstart[ROUTE[RT_EXP + 2 * t + 1]] + ROUTE[RT_RANK + 2 * t + 1]; const float w0 = ((const float*)ROUTE)[RT_WGT + 2 * t], w1 = ((const float*)ROUTE)[RT_WGT + 2 * t + 1];
                f32x4 v[8]; float ss = 0.f;
#pragma unroll
                for (int j = 0; j < 8; ++j) { v[j] = ((const f32x4*)(XF + (size_t)t * DM))[lane + 64 * j];
                    const u32x2 y0 = ((const u32x2*)(YB + (size_t)d0 * DM))[lane + 64 * j], y1 = ((const u32x2*)(YB + (size_t)d1 * DM))[lane + 64 * j];
                    v[j].x += w0 * bflo(y0.x) + w1 * bflo(y1.x); v[j].y += w0 * bfhi(y0.x) + w1 * bfhi(y1.x); v[j].z += w0 * bflo(y0.y) + w1 * bflo(y1.y); v[j].w += w0 * bfhi(y0.y) + w1 * bfhi(y1.y);
                    ss += (v[j].x * v[j].x + v[j].y * v[j].y) + (v[j].z * v[j].z + v[j].w * v[j].w); }
                ss = wave_sum(ss); const float rs = 1.0f / sqrtf(ss * (1.0f / DM) + EPS);
                if (l == NLAYER - 1) {
#pragma unroll
                    for (int j = 0; j < 8; ++j) { const f32x4 g = ((const f32x4*)nfin)[lane + 64 * j]; ((f32x4*)((float*)kin[28] + (size_t)t * DM))[lane + 64 * j] = (f32x4){v[j].x * rs * g.x, v[j].y * rs * g.y, v[j].z * rs * g.z, v[j].w * rs * g.w}; }
                } else {
#pragma unroll
                    for (int j = 0; j < 8; ++j) { ((f32x4*)(XF + (size_t)t * DM))[lane + 64 * j] = v[j]; u32x2 o; o.x = pk2(v[j].x * rs, v[j].y * rs); o.y = pk2(v[j].z * rs, v[j].w * rs); ((u32x2*)(XB + (size_t)t * DM))[lane + 64 * j] = o; }
                    if (lane == 0) RSTD[t] = rs;
                }
            }
        }
        SEAM(pb + 17);
    }
#if DBG_STOP >= 0
    if (IN(NPH)) { PTRS();
        const unsigned* w = (const unsigned*)(wsl + 2 * MiB); const size_t nw = (WS_END - 2 * MiB) / 4; float* out = (float*)kin[28];
        for (int i = gt; i < NT * DM; i += ngt) { unsigned h = 0u; for (size_t j = (size_t)i; j < nw; j += (size_t)NT * DM) { const size_t b = 2 * MiB + 4 * j; const bool skip = false; if (!skip) h = h * 0x9E3779B1u + w[j]; } out[i] = (float)(h & 0xffffu); }
    }
#endif
#undef IN
#undef SEAM
}
}

extern "C" void kernel_launch(void* const* d_in, const int* in_sizes, int n_in, void* d_out, int out_size, void* d_ws, size_t ws_size, hipStream_t stream) {
    static int grid = 0;
    if (grid == 0) {
        if (n_in != 28 || out_size != NT * DM || ws_size < WS_END) { fprintf(stderr, "kernel_launch: unexpected problem (n_in %d out %d ws %zu need %zu)\n", n_in, out_size, ws_size, (size_t)WS_END); grid = -1; return; }
        int dev = 0, cus = 0, per_cu = 0;
        if (hipGetDevice(&dev) != hipSuccess || hipDeviceGetAttribute(&cus, hipDeviceAttributeMultiprocessorCount, dev) != hipSuccess) { grid = -1; return; }
        if (hipFuncSetAttribute((const void*)mk_fwd, hipFuncAttributeMaxDynamicSharedMemorySize, LDS_BYTES) != hipSuccess) { fprintf(stderr, "kernel_launch: hipFuncSetAttribute failed\n"); grid = -1; return; }
        if (hipOccupancyMaxActiveBlocksPerMultiprocessor(&per_cu, (const void*)mk_fwd, 512, LDS_BYTES) != hipSuccess || per_cu < 1) fprintf(stderr, "kernel_launch: occupancy query reports %d\n", per_cu);
        (void)hipGetLastError();
        grid = cus;
    }
    if (grid < 0) return;
    (void)hipMemsetAsync((char*)d_ws + WS_CTL, 0, CTL_BYTES, stream);
    Args a{};
    for (int i = 0; i < 28; ++i) a.in[i] = d_in[i];
    a.out = (float*)d_out; a.ws = (unsigned char*)d_ws;
#if MK_ONE_LAUNCH
    a.ph_lo = 0; a.ph_hi = NPH;
    hipLaunchKernelGGL(mk_fwd, dim3(grid), dim3(512), LDS_BYTES, stream, a);
#else
#if DBG_STOP >= 0
    for (int p = 0; p <= DBG_STOP; ++p) { a.ph_lo = p; a.ph_hi = p + 1; hipLaunchKernelGGL(mk_fwd, dim3(grid), dim3(512), LDS_BYTES, stream, a); }
    a.ph_lo = NPH; a.ph_hi = NPH + 1; hipLaunchKernelGGL(mk_fwd, dim3(grid), dim3(512), LDS_BYTES, stream, a);
#else
    for (int p = 0; p < NPH; ++p) { a.ph_lo = p; a.ph_hi = p + 1; hipLaunchKernelGGL(mk_fwd, dim3(grid), dim3(512), LDS_BYTES, stream, a); }
#endif
#endif
}
```
